# Optimizing an MI355X kernel written in HIP

```python
import math
import jax, jax.numpy as jnp
from jax import lax
import numpy as np

D_MODEL = 2048
BATCH = 4
SEQ = 4096
DEPTH = 2

N_MEM = 256
EPS = 1e-6
GLA_HEADS = 4
GLA_DV = D_MODEL // 2 // GLA_HEADS
GLA_DK = GLA_DV // 2
GLA_RANK = 16
GLA_TAU = 16.0
GLA_CHUNK = 64
DSA_HEADS = 8
DSA_DH = D_MODEL // 2 // DSA_HEADS
IDX_HEADS = 16
IDX_DH = 64
TOPK_MAX = 256
DSA_QBLOCK = 64
REL_BUCKETS = 32
REL_MAX_DIST = 128
XA_HEADS = 4
XA_DH = D_MODEL // XA_HEADS
D_FF = -(-8 * D_MODEL // (3 * 256)) * 256
IN_SPLITS = [
    GLA_HEADS * GLA_DK,
    GLA_HEADS * GLA_DK,
    GLA_HEADS * GLA_DV,
    GLA_RANK,
    GLA_HEADS * GLA_DV,
    DSA_HEADS * DSA_DH,
    DSA_HEADS * DSA_DH,
    DSA_HEADS * DSA_DH,
    IDX_HEADS * IDX_DH,
    IDX_DH,
    IDX_HEADS,
]
D_IN = sum(IN_SPLITS)

kernel_name = "hymba_gla_dsa_sandwich_block"


def rmsnorm(x, g):
    xf = x.astype(jnp.float32)
    y = xf * lax.rsqrt(jnp.mean(xf * xf, axis=-1, keepdims=True) + EPS) * g.astype(jnp.float32)
    return y.astype(x.dtype)


def gla_mixer(q, k, v, z, r, w_gate_up, b_gate, g_head):
    f32 = jnp.float32
    B, L, _ = q.shape
    C = GLA_CHUNK
    N = L // C
    logg = jax.nn.log_sigmoid(z.astype(f32) @ w_gate_up.astype(f32) + b_gate.astype(f32)) / GLA_TAU

    def heads(t, d):
        return t.astype(f32).reshape(B, N, C, GLA_HEADS, d).transpose(0, 1, 3, 2, 4)

    qc = heads(q, GLA_DK) * GLA_DK ** -0.5
    kc = heads(k, GLA_DK)
    vc = heads(v, GLA_DV)
    bcum = jnp.cumsum(heads(logg, GLA_DK), axis=3)
    b_last = bcum[:, :, :, -1:, :]
    q_dec = qc * jnp.exp(bcum)
    k_intra = kc * jnp.exp(-bcum)
    k_state = kc * jnp.exp(b_last - bcum)
    causal = jnp.tril(jnp.ones((C, C), dtype=bool))
    a = jnp.where(causal, jnp.einsum('bnhid,bnhjd->bnhij', q_dec, k_intra), 0.0)
    o_intra = jnp.einsum('bnhij,bnhjv->bnhiv', a, vc)
    upd = jnp.einsum('bnhjd,bnhjv->bnhdv', k_state, vc)
    decay = jnp.exp(b_last[:, :, :, 0, :])

    def step(s, inp):
        u, d = inp
        return d[..., None] * s + u, s

    s0 = jnp.zeros((B, GLA_HEADS, GLA_DK, GLA_DV), f32)
    _, s_prev = lax.scan(step, s0, (upd.transpose(1, 0, 2, 3, 4), decay.transpose(1, 0, 2, 3)))
    s_prev = s_prev.transpose(1, 0, 2, 3, 4)
    o = o_intra + jnp.einsum('bnhid,bnhdv->bnhiv', q_dec, s_prev)
    o = o * lax.rsqrt(jnp.mean(o * o, axis=-1, keepdims=True) + EPS) * g_head.astype(f32)
    o = o.transpose(0, 1, 3, 2, 4).reshape(B, L, GLA_HEADS * GLA_DV)
    return (o * jax.nn.silu(r.astype(f32))).astype(q.dtype)


def rel_bucket(dist):
    n = jnp.maximum(dist, 0)
    max_exact = REL_BUCKETS // 2
    nf = jnp.maximum(n, 1).astype(jnp.float32)
    large = max_exact + (jnp.log(nf / max_exact) / math.log(REL_MAX_DIST / max_exact)
                         * (REL_BUCKETS - max_exact)).astype(jnp.int32)
    large = jnp.minimum(large, REL_BUCKETS - 1)
    return jnp.where(n < max_exact, n, large)


def dsa_mixer(q, k, v, qi, ki, wi, rel_table):
    f32 = jnp.float32
    B, L, _ = q.shape
    topk = min(TOPK_MAX, L // 4)
    TQ = DSA_QBLOCK
    NB = L // TQ
    qh = q.reshape(B, L, DSA_HEADS, DSA_DH)
    kh = k.reshape(B, L, DSA_HEADS, DSA_DH)
    vh = v.reshape(B, L, DSA_HEADS, DSA_DH)
    qih = qi.reshape(B, L, IDX_HEADS, IDX_DH)
    kif = ki.astype(f32)
    w_sc = wi.astype(f32) * (IDX_HEADS ** -0.5 * IDX_DH ** -0.5)
    key_pos = jnp.arange(L)

    def blocks(t):
        return t.reshape(B, NB, TQ, *t.shape[2:]).swapaxes(0, 1)

    def one_block(inp):
        start, q_b, qi_b, w_b = inp
        q_pos = start + jnp.arange(TQ)
        rel = jax.nn.relu(jnp.einsum('bthd,bsd->bths', qi_b.astype(f32), kif))
        score = jnp.einsum('bths,bth->bts', rel, w_b)
        visible = key_pos[None, :] <= q_pos[:, None]
        score = jnp.where(visible, score, -jnp.inf)
        _, idx = lax.top_k(score, topk)
        valid = idx <= q_pos[None, :, None]
        kg = jax.vmap(lambda kb, ib: kb[ib])(kh, idx)
        vg = jax.vmap(lambda vb, ib: vb[ib])(vh, idx)
        bias = rel_table[rel_bucket(q_pos[None, :, None] - idx)]
        logits = (jnp.einsum('bthd,btkhd->bthk', q_b, kg).astype(f32) * DSA_DH ** -0.5
                  + bias.astype(f32).transpose(0, 1, 3, 2))
        logits = jnp.where(valid[:, :, None, :], logits, -1e30)
        p = jax.nn.softmax(logits, axis=-1)
        return jnp.einsum('bthk,btkhd->bthd', p.astype(vg.dtype), vg)

    starts = jnp.arange(NB, dtype=jnp.int32) * TQ
    out = lax.map(one_block, (starts, blocks(qh), blocks(qih), blocks(w_sc)))
    return out.swapaxes(0, 1).reshape(B, L, DSA_HEADS * DSA_DH)


def cross_attn(h, mem_n, wq, wkv, wo):
    B, L, _ = h.shape
    M = mem_n.shape[1]
    q = (h @ wq).reshape(B, L, XA_HEADS, XA_DH)
    k, v = jnp.split(mem_n @ wkv, 2, axis=-1)
    k = k.reshape(B, M, XA_HEADS, XA_DH)
    v = v.reshape(B, M, XA_HEADS, XA_DH)
    logits = jnp.einsum('bthd,bmhd->bhtm', q, k).astype(jnp.float32) * XA_DH ** -0.5
    p = jax.nn.softmax(logits, axis=-1)
    o = jnp.einsum('bhtm,bmhd->bthd', p.astype(v.dtype), v).reshape(B, L, D_MODEL)
    return o @ wo


def swiglu(h, w_in, w_out):
    g, u = jnp.split(h @ w_in, 2, axis=-1)
    return (jax.nn.silu(g) * u) @ w_out


def setup_inputs(seed: int = 0) -> dict:
    key = jax.random.key(seed)
    ks = jax.random.split(key, 16)
    f32 = jnp.float32
    nrm = lambda k, shape, s: jax.random.normal(k, shape, f32) * s
    return {
        "x": nrm(ks[0], (BATCH, SEQ, D_MODEL), 1.0),
        "mem": nrm(ks[1], (BATCH, N_MEM, D_MODEL), 1.0),
        "norm_gains": 1.0 + nrm(ks[2], (DEPTH, 7, D_MODEL), 0.02),
        "w_in": nrm(ks[3], (DEPTH, D_MODEL, D_IN), D_MODEL ** -0.5),
        "w_gate_up": nrm(ks[4], (DEPTH, GLA_RANK, GLA_HEADS * GLA_DK), GLA_RANK ** -0.5),
        "b_gate": nrm(ks[5], (DEPTH, GLA_HEADS * GLA_DK), 0.01),
        "gla_head_gain": 1.0 + nrm(ks[6], (DEPTH, GLA_DV), 0.02),
        "rel_table": nrm(ks[7], (REL_BUCKETS, DSA_HEADS), 0.1),
        "w_out": nrm(ks[8], (DEPTH, D_MODEL, D_MODEL), D_MODEL ** -0.5),
        "w_xq": nrm(ks[9], (DEPTH, D_MODEL, D_MODEL), D_MODEL ** -0.5),
        "w_xkv": nrm(ks[10], (DEPTH, D_MODEL, 2 * D_MODEL), D_MODEL ** -0.5),
        "w_xo": nrm(ks[11], (DEPTH, D_MODEL, D_MODEL), D_MODEL ** -0.5),
        "w_ffn_in": nrm(ks[12], (DEPTH, D_MODEL, 2 * D_FF), D_MODEL ** -0.5),
        "w_ffn_out": nrm(ks[13], (DEPTH, D_FF, D_MODEL), D_FF ** -0.5),
    }


def reference(x, mem, norm_gains, w_in, w_gate_up, b_gate, gla_head_gain, rel_table,
              w_out, w_xq, w_xkv, w_xo, w_ffn_in, w_ffn_out):
    offsets = np.cumsum(IN_SPLITS)[:-1].tolist()
    for l in range(DEPTH):
        g = norm_gains[l]
        h = rmsnorm(x, g[0])
        proj = h @ w_in[l]
        gq, gk, gv, gz, gr, dq, dk, dv, iq, ik, iw = jnp.split(proj, offsets, axis=-1)
        o_gla = gla_mixer(gq, gk, gv, gz, gr, w_gate_up[l], b_gate[l], gla_head_gain[l])
        o_dsa = dsa_mixer(dq, dk, dv, iq, ik, iw, rel_table)
        mix = jnp.concatenate([o_gla, o_dsa.astype(o_gla.dtype)], axis=-1) @ w_out[l]
        x = x + rmsnorm(mix, g[1])
        h = rmsnorm(x, g[2])
        mem_n = rmsnorm(mem, g[6])
        x = x + rmsnorm(cross_attn(h, mem_n, w_xq[l], w_xkv[l], w_xo[l]), g[3])
        h = rmsnorm(x, g[4])
        x = x + rmsnorm(swiglu(h, w_ffn_in[l], w_ffn_out[l]), g[5])
    return x
```

```cpp
#include <hip/hip_runtime.h>
#include <cstdio>
#include <cstdint>

#ifndef MK_MULTI
#define MK_MULTI 0
#endif

#define LAS __attribute__((address_space(3)))
#define GAS __attribute__((address_space(1)))
typedef unsigned short bf16;
typedef short bf16x8 __attribute__((ext_vector_type(8)));
typedef short s16x4 __attribute__((ext_vector_type(4)));
typedef float f32x2 __attribute__((ext_vector_type(2)));
typedef float f32x4 __attribute__((ext_vector_type(4)));
typedef float f32x16 __attribute__((ext_vector_type(16)));
typedef unsigned u32x2 __attribute__((ext_vector_type(2)));
typedef unsigned u32x4 __attribute__((ext_vector_type(4)));
typedef GAS unsigned gu32;

namespace pg8 {
#define PG8_LAS __attribute__((address_space(3)))
typedef unsigned short bf16_t;
constexpr int BM = 256, BK = 64, HALF = 128, HTB = HALF * BK * 2  , STAGE_BYTES = 8 * HTB, NXCD = 8, WGM = 8;

__host__ __device__ __forceinline__ int lds_byte(int r, int c) { const int st = (r >> 4) * 2 + (c >> 5), rr = r & 15, cc = c & 31, ob = rr * 64 + cc * 2; return st * 1024 + (ob ^ (((ob >> 9) & 1) << 5)); }
__host__ __device__ __forceinline__ void stage_rc(int b, int& R, int& C) { const int st = b / 1024, sb = b % 1024, swz = sb ^ (((sb >> 9) & 1) << 5); R = (st >> 1) * 16 + swz / 64; C = (st & 1) * 32 + (swz % 64) / 2; }
__host__ __device__ __forceinline__ int perm32(int rho) { const int n = rho >> 4, i = rho & 15; return 8 * (i >> 2) + 4 * n + (i & 3); }

struct Unit { int pm, pn; const char* a; const char* b; size_t c; bf16_t* o; int ldc; const float* rs; float osc; };

__device__ __forceinline__ bool static_order(int i, int G, int c, int nM, int nN, int& pm, int& pn) {
    const int nwg = nM * nN; const long L = (long)i * G + c; if (L >= nwg) return false;
    int wgid = (int)L; { const int q = nwg / NXCD, r = nwg % NXCD, xcd = wgid % NXCD, off = wgid / NXCD; wgid = (xcd < r ? xcd * (q + 1) : r * (q + 1) + (xcd - r) * q) + off; }
    const int nig = WGM * nN, gid = wgid / nig, fm = gid * WGM, gsz = (nM - fm) < WGM ? (nM - fm) : WGM;
    pm = fm + ((wgid % nig) % gsz); pn = (wgid % nig) / gsz; return true;
}
struct PlainSched {
    const bf16_t* A; const bf16_t* Bt; int lda, ldb, nM, nN, G, c, bper; size_t bstride, crs, ccs;
    __device__ __forceinline__ bool next(int i, Unit& u) const {
        if (!static_order(i, G, c, nM, nN, u.pm, u.pn)) return false;
        u.a = (const char*)(A + (size_t)u.pm * BM * lda);
        u.b = (const char*)(Bt + (bper ? (size_t)(u.pm / bper) * bstride : (size_t)0) + (size_t)u.pn * BM * ldb);
        u.c = (size_t)u.pm * crs + (size_t)u.pn * ccs;
        return true;
    }
    __device__ __forceinline__ void a_ready(const Unit&) const {}
    __device__ __forceinline__ void done(const Unit&) const {}
};

typedef int i32x8 __attribute__((ext_vector_type(8)));
typedef int i32x4 __attribute__((ext_vector_type(4)));
__device__ __forceinline__ i32x8 cat8(bf16x8 a, bf16x8 b) { const i32x4 x = __builtin_bit_cast(i32x4, a), y = __builtin_bit_cast(i32x4, b); return __builtin_shufflevector(x, y, 0, 1, 2, 3, 4, 5, 6, 7); }
__device__ __forceinline__ unsigned cvt_pk_bf16(float lo, float hi) { unsigned r; asm volatile("v_cvt_pk_bf16_f32 %0, %1, %2" : "=v"(r) : "v"(lo), "v"(hi)); return r; }

struct EpiBf16 {
    static constexpr bool PERM = true, AFTER_DRAIN = false;
    bf16_t* O; int ldc;
    __device__ __forceinline__ void operator()(const f32x4 (&acc)[2][2][4][2], const Unit& u, int wr, int wc, int fr, int fq) const {
        bf16_t* base = O + u.c + (size_t)(wr * 64 + fr) * ldc + wc * 32 + 8 * fq;
#pragma unroll
        for (int ai = 0; ai < 2; ++ai)
#pragma unroll
            for (int m = 0; m < 4; ++m) { bf16_t* rowp = base + (size_t)(ai * HALF + m * 16) * ldc;
#pragma unroll
                for (int bj = 0; bj < 2; ++bj) { const f32x4 v0 = acc[ai][bj][m][0], v1 = acc[ai][bj][m][1];
                    u32x4 w; w.x = cvt_pk_bf16(v0[0], v0[1]); w.y = cvt_pk_bf16(v0[2], v0[3]); w.z = cvt_pk_bf16(v1[0], v1[1]); w.w = cvt_pk_bf16(v1[2], v1[3]);
                    *(u32x4*)(rowp + bj * HALF) = w; } }
    }
};
__device__ __forceinline__ unsigned pk4_e4m3(float a, float b, float c, float d) { unsigned w = 0u; w = __builtin_amdgcn_cvt_pk_fp8_f32(a, b, w, false); w = __builtin_amdgcn_cvt_pk_fp8_f32(c, d, w, true); return w; }
struct EpiBf16U {
    static constexpr bool PERM = true, AFTER_DRAIN = false;
    bf16_t* ikc;
    unsigned char* v8t;
    unsigned char* q8;
    unsigned char* k8;
    __device__ __forceinline__ void operator()(const f32x4 (&acc)[2][2][4][2], const Unit& u, int wr, int wc, int fr, int fq) const {
        const int ldc = u.ldc; const float* rs = u.rs;
        bf16_t* base = u.o + u.c + (size_t)(wr * 64 + fr) * ldc + wc * 32 + 8 * fq;
#pragma unroll
        for (int ai = 0; ai < 2; ++ai)
#pragma unroll
            for (int m = 0; m < 4; ++m) { bf16_t* rowp = base + (size_t)(ai * HALF + m * 16) * ldc;
                const float sc = rs ? u.osc / sqrtf(rs[u.pm * BM + wr * 64 + fr + ai * HALF + m * 16] * (1.0f / 2048.0f) + 1e-6f) : u.osc;
#pragma unroll
                for (int bj = 0; bj < 2; ++bj) { const f32x4 v0 = acc[ai][bj][m][0] * sc, v1 = acc[ai][bj][m][1] * sc;
                    u32x4 w; w.x = cvt_pk_bf16(v0[0], v0[1]); w.y = cvt_pk_bf16(v0[2], v0[3]); w.z = cvt_pk_bf16(v1[0], v1[1]); w.w = cvt_pk_bf16(v1[2], v1[3]);
                    if (!(u.pn >= 12 && u.pn < 24 && u.ldc != 4096)) *(u32x4*)(rowp + bj * HALF) = w;
                    if (u.pn >= 20 && u.pn < 24 && u.ldc != 4096) { const unsigned a0 = pk4_e4m3(v0[0], v0[1], v0[2], v0[3]), a1 = pk4_e4m3(v1[0], v1[1], v1[2], v1[3]);
                        const int row = u.pm * BM + wr * 64 + fr + ai * HALF + m * 16, col = (u.pn - 20) * 256 + bj * HALF + wc * 32 + 8 * fq;
                        unsigned char* vp = v8t + ((size_t)(row >> 12) * 1024 + col) * 4096 + (row & 4095);
                        vp[0] = (unsigned char)a0; vp[4096] = (unsigned char)(a0 >> 8); vp[2 * 4096] = (unsigned char)(a0 >> 16); vp[3 * 4096] = (unsigned char)(a0 >> 24);
                        vp[4 * 4096] = (unsigned char)a1; vp[5 * 4096] = (unsigned char)(a1 >> 8); vp[6 * 4096] = (unsigned char)(a1 >> 16); vp[7 * 4096] = (unsigned char)(a1 >> 24); }
                    if (u.pn >= 12 && u.pn < 16 && u.ldc != 4096) { u32x2 w8; w8.x = pk4_e4m3(v0[0], v0[1], v0[2], v0[3]); w8.y = pk4_e4m3(v1[0], v1[1], v1[2], v1[3]);
                        *(u32x2*)(q8 + (size_t)(u.pm * BM + wr * 64 + fr + ai * HALF + m * 16) * 1024 + (u.pn - 12) * 256 + bj * HALF + wc * 32 + 8 * fq) = w8; }
                    if (u.pn >= 16 && u.pn < 20 && u.ldc != 4096) { u32x2 w8; w8.x = pk4_e4m3(v0[0], v0[1], v0[2], v0[3]); w8.y = pk4_e4m3(v1[0], v1[1], v1[2], v1[3]);
                        *(u32x2*)(k8 + (size_t)(u.pm * BM + wr * 64 + fr + ai * HALF + m * 16) * 1024 + (u.pn - 16) * 256 + bj * HALF + wc * 32 + 8 * fq) = w8; }
                    if (bj == 0 && u.pn == 28 && u.ldc != 4096) { const int tc = wc * 32 + 8 * fq; if (tc >= 16 && tc < 80) *(u32x4*)(ikc + (size_t)(u.pm * BM + wr * 64 + fr + ai * HALF + m * 16) * 64 + (tc - 16)) = w; } } }
    }
};
struct EpiBf16Part {
    static constexpr bool PERM = true, AFTER_DRAIN = false;
    bf16_t* O; float* part; float osc;
    __device__ __forceinline__ void operator()(const f32x4 (&acc)[2][2][4][2], const Unit& u, int wr, int wc, int fr, int fq) const {
        const int row0 = u.pm * BM + wr * 64 + fr, col0 = u.pn * BM + wc * 32 + 8 * fq;
#pragma unroll
        for (int ai = 0; ai < 2; ++ai)
#pragma unroll
            for (int m = 0; m < 4; ++m) { const int row = row0 + ai * HALF + m * 16; bf16_t* rowp = O + (size_t)row * 2048 + col0; float ss = 0.f;
#pragma unroll
                for (int bj = 0; bj < 2; ++bj) { const f32x4 v0 = acc[ai][bj][m][0] * osc, v1 = acc[ai][bj][m][1] * osc;
                    ss += (v0[0] * v0[0] + v0[1] * v0[1]) + (v0[2] * v0[2] + v0[3] * v0[3]) + (v1[0] * v1[0] + v1[1] * v1[1]) + (v1[2] * v1[2] + v1[3] * v1[3]);
                    u32x4 w; w.x = cvt_pk_bf16(v0[0], v0[1]); w.y = cvt_pk_bf16(v0[2], v0[3]); w.z = cvt_pk_bf16(v1[0], v1[1]); w.w = cvt_pk_bf16(v1[2], v1[3]);
                    *(u32x4*)(rowp + bj * HALF) = w; }
                ss += __shfl_xor(ss, 16); ss += __shfl_xor(ss, 32);
                if (fq == 0) part[(size_t)row * 32 + u.pn * 4 + wc] = ss; }
    }
};
struct EpiF32 {
    static constexpr bool PERM = false, AFTER_DRAIN = false;
    float* C; int ldc;
    __device__ __forceinline__ void operator()(const f32x4 (&acc)[2][2][4][2], const Unit& u, int wr, int wc, int fr, int fq) const {
        const int row0 = u.pm * BM + wr * 64 + fr, col0 = u.pn * BM + wc * 32 + 4 * fq;
#pragma unroll
        for (int ai = 0; ai < 2; ++ai)
#pragma unroll
            for (int m = 0; m < 4; ++m) { float* rowp = C + (size_t)(row0 + ai * HALF + m * 16) * ldc + col0;
#pragma unroll
                for (int bj = 0; bj < 2; ++bj)
#pragma unroll
                    for (int n = 0; n < 2; ++n) *(f32x4*)(rowp + bj * HALF + n * 16) = acc[ai][bj][m][n]; }
    }
};
struct EpiSwiglu8 {
    static constexpr bool PERM = true, AFTER_DRAIN = false;
    unsigned char* O; int ldc; const float* rs; float isc, osc;
    __device__ __forceinline__ void operator()(const f32x4 (&acc)[2][2][4][2], const Unit& u, int wr, int wc, int fr, int fq) const {
        const int row0 = u.pm * BM + wr * 64 + fr, col0 = u.pn * HALF + wc * 32 + 8 * fq;
#pragma unroll
        for (int ai = 0; ai < 2; ++ai)
#pragma unroll
            for (int m = 0; m < 4; ++m) { unsigned char* rowp = O + (size_t)(row0 + ai * HALF + m * 16) * ldc + col0; float o[8];
                const float sc = isc / sqrtf(rs[row0 + ai * HALF + m * 16] * (1.0f / 2048.0f) + 1e-6f);
                const float cr = -1.4426950408889634f * sc, kr = sc * sc * osc;
#pragma unroll
                for (int n = 0; n < 2; ++n)
#pragma unroll
                    for (int j = 0; j < 4; ++j) { const float g = acc[ai][0][m][n][j], up = acc[ai][1][m][n][j];
                        o[n * 4 + j] = (g * up) * kr * __builtin_amdgcn_rcpf(1.0f + __builtin_amdgcn_exp2f(g * cr)); }
                u32x2 w; w.x = pk4_e4m3(o[0], o[1], o[2], o[3]); w.y = pk4_e4m3(o[4], o[5], o[6], o[7]);
                *(u32x2*)rowp = w; }
    }
};
struct EpiSoftmaxP {
    static constexpr bool PERM = true, AFTER_DRAIN = false;
    bf16_t* P; const float* rs; PG8_LAS float* tabM; PG8_LAS float* tabS;
    __device__ __forceinline__ void operator()(const f32x4 (&acc)[2][2][4][2], const Unit& u, int wr, int wc, int fr, int fq) const {
        const int row0 = u.pm * BM + wr * 64 + fr, col0 = u.pn * BM + wc * 32 + 8 * fq;
        float c2[2][4], mx[2][4];
#pragma unroll
        for (int ai = 0; ai < 2; ++ai)
#pragma unroll
            for (int m = 0; m < 4; ++m) { const int lr = ai * HALF + wr * 64 + m * 16 + fr;
                c2[ai][m] = (1.4426950408889634f * 0.04419417382415922f) / sqrtf(rs[u.pm * BM + lr] * (1.0f / 2048.0f) + 1e-6f);
                float v = acc[ai][0][m][0][0];
#pragma unroll
                for (int bj = 0; bj < 2; ++bj)
#pragma unroll
                    for (int n = 0; n < 2; ++n)
#pragma unroll
                        for (int j = 0; j < 4; ++j) v = fmaxf(v, acc[ai][bj][m][n][j]);
                v = fmaxf(v, __shfl_xor(v, 16)); v = fmaxf(v, __shfl_xor(v, 32));
                if (fq == 0) tabM[lr * 4 + wc] = v; }
        asm volatile("s_waitcnt lgkmcnt(0)" ::: "memory"); __builtin_amdgcn_s_barrier(); asm volatile("" ::: "memory");
        float e[2][4][16];
#pragma unroll
        for (int ai = 0; ai < 2; ++ai)
#pragma unroll
            for (int m = 0; m < 4; ++m) { const int lr = ai * HALF + wr * 64 + m * 16 + fr;
                const f32x4 t = *(const PG8_LAS f32x4*)(tabM + lr * 4); const float rm = fmaxf(fmaxf(t.x, t.y), fmaxf(t.z, t.w)); mx[ai][m] = rm;
                float s = 0.f;
#pragma unroll
                for (int bj = 0; bj < 2; ++bj)
#pragma unroll
                    for (int n = 0; n < 2; ++n)
#pragma unroll
                        for (int j = 0; j < 4; ++j) { const float p = __builtin_amdgcn_exp2f((acc[ai][bj][m][n][j] - rm) * c2[ai][m]); e[ai][m][bj * 8 + n * 4 + j] = p; s += p; }
                s += __shfl_xor(s, 16); s += __shfl_xor(s, 32);
                if (fq == 0) tabS[lr * 4 + wc] = s; }
        asm volatile("s_waitcnt lgkmcnt(0)" ::: "memory"); __builtin_amdgcn_s_barrier(); asm volatile("" ::: "memory");
#pragma unroll
        for (int ai = 0; ai < 2; ++ai)
#pragma unroll
            for (int m = 0; m < 4; ++m) { const int lr = ai * HALF + wr * 64 + m * 16 + fr;
                const f32x4 t = *(const PG8_LAS f32x4*)(tabS + lr * 4); const float inv = 1.0f / ((t.x + t.y) + (t.z + t.w));
                bf16_t* rowp = P + (size_t)(row0 + ai * HALF + m * 16) * 1024 + col0;
#pragma unroll
                for (int bj = 0; bj < 2; ++bj) { const float* q = &e[ai][m][bj * 8];
                    u32x4 w; w.x = cvt_pk_bf16(q[0] * inv, q[1] * inv); w.y = cvt_pk_bf16(q[2] * inv, q[3] * inv); w.z = cvt_pk_bf16(q[4] * inv, q[5] * inv); w.w = cvt_pk_bf16(q[6] * inv, q[7] * inv);
                    *(u32x4*)(rowp + bj * HALF) = w; } }
    }
};
struct EpiSwiglu {
    static constexpr bool PERM = true, AFTER_DRAIN = false;
    bf16_t* O; int ldc; const float* rs;
    __device__ __forceinline__ void operator()(const f32x4 (&acc)[2][2][4][2], const Unit& u, int wr, int wc, int fr, int fq) const {
        const int row0 = u.pm * BM + wr * 64 + fr, col0 = u.pn * HALF + wc * 32 + 8 * fq;
#pragma unroll
        for (int ai = 0; ai < 2; ++ai)
#pragma unroll
            for (int m = 0; m < 4; ++m) { bf16_t* rowp = O + (size_t)(row0 + ai * HALF + m * 16) * ldc + col0; float o[8];
                const float sc = 1.0f / sqrtf(rs[row0 + ai * HALF + m * 16] * (1.0f / 2048.0f) + 1e-6f);
#pragma unroll
                for (int n = 0; n < 2; ++n)
#pragma unroll
                    for (int j = 0; j < 4; ++j) { const float g = acc[ai][0][m][n][j] * sc, up = acc[ai][1][m][n][j] * sc;
                        o[n * 4 + j] = g * __builtin_amdgcn_rcpf(1.0f + __builtin_amdgcn_exp2f(-1.4426950408889634f * g)) * up; }
                u32x4 w; w.x = cvt_pk_bf16(o[0], o[1]); w.y = cvt_pk_bf16(o[2], o[3]); w.z = cvt_pk_bf16(o[4], o[5]); w.w = cvt_pk_bf16(o[6], o[7]);
                *(u32x4*)rowp = w; }
    }
};

#define PG8_ITER_SP2 do { \
            PG8_LDB(B0, 0, 0); PG8_LDB(B1, 0, 1); PG8_SCHED; PG8_LDA(At, 0, 0); PG8_STAGE(PG8_SA(1, 1), a1 + hstepA, voffA); \
            PG8_WAIT_V(8); PG8_WAIT_L(0); PG8_BAR; PG8_MMA(0, 0, At, B0); PG8_MMA(0, 1, At, B1); PG8_BAR; PG8_SCHED; \
            PG8_LDA(At, 0, 1); PG8_STAGE(PG8_SB(0, 0), b2, voffB); PG8_STAGE(PG8_SB(0, 1), b2 + hstepB, voffB); PG8_STAGE(PG8_SA(0, 0), a2, voffA); \
            PG8_WAIT_V(8); PG8_WAIT_L(0); PG8_BAR; PG8_MMA(1, 0, At, B0); PG8_MMA(1, 1, At, B1); PG8_BAR; PG8_SCHED; \
            PG8_LDB(B0, 1, 0); PG8_LDB(B1, 1, 1); PG8_SCHED; PG8_LDA(At, 1, 0); PG8_STAGE(PG8_SA(0, 1), a2 + hstepA, voffA); \
            PG8_WAIT_V(8); PG8_WAIT_L(0); PG8_BAR; PG8_MMA(0, 0, At, B0); PG8_MMA(0, 1, At, B1); PG8_BAR; PG8_SCHED; \
            PG8_LDA(At, 1, 1); PG8_STAGE(PG8_SB(1, 0), b3, voffB); PG8_STAGE(PG8_SB(1, 1), b3 + hstepB, voffB); PG8_STAGE(PG8_SA(1, 0), a3, voffA); \
            PG8_WAIT_V(8); PG8_WAIT_L(0); PG8_BAR; PG8_MMA(1, 0, At, B0); PG8_MMA(1, 1, At, B1); PG8_BAR; PG8_SCHED; \
            } while (0)
template <class Epi, class Sched, bool ALIGN_EPI = false, bool SP2 = false, bool FP8 = false, int MIXK = 0>
__device__ __forceinline__ void gemm_phase(PG8_LAS unsigned char* lds, const int K, const int lda, const int ldb, const Sched& S, const Epi& E) {
    int tid_ = threadIdx.x; asm volatile("" : "+v"(tid_));
    const int tid = tid_, wid = __builtin_amdgcn_readfirstlane(tid >> 6), lane = tid & 63, wr = wid >> 2, wc = wid & 3, fr = lane & 15, fq = lane >> 4;
    const int nt = K / BK;
    unsigned voffA[2], voffB[2];
#pragma unroll
    for (int i = 0; i < 2; ++i) { int R, C; stage_rc(tid * 16 + i * 8192, R, C); const int Rb = Epi::PERM ? ((R & ~31) + perm32(R & 31)) : R;
        voffA[i] = (unsigned)(R * lda + C) * 2u; voffB[i] = (unsigned)(Rb * ldb + C) * 2u; }
    const size_t kstep = (size_t)(BK * 2);
    const size_t hstepA = (size_t)HALF * lda * 2, hstepB = (size_t)HALF * ldb * 2;
    const unsigned ldsw = (unsigned)wid * 1024u;
    const int aoff = lds_byte(wr * 64 + fr, fq * 8), boff = lds_byte(wc * 32 + fr, fq * 8);
#define PG8_SA(b, h) (((b) * 2 + (h)) * HTB)
#define PG8_SB(b, h) ((4 + (b) * 2 + (h)) * HTB)
#define PG8_STAGE(bufoff, gbase, voff) do { const char* gb_ = (const char*)(gbase); asm volatile("" : "+s"(gb_)); _Pragma("unroll") for (int _i = 0; _i < 2; ++_i) { unsigned vo_ = (voff)[_i]; asm volatile("" : "+v"(vo_));     \
        __builtin_amdgcn_global_load_lds((const unsigned*)(gb_ + vo_), (PG8_LAS unsigned*)(lds + (bufoff) + ldsw + _i * 8192), 16, 0, 0); } } while (0)
#define PG8_LDA(dst, b, h) do { if constexpr (FP8 || (MIXK > 0 && PG8_F8SEL)) { _Pragma("unroll") for (int m = 0; m < 4; ++m) { const i32x4 lo_ = *(const PG8_LAS i32x4*)(lds + PG8_SA(b, h) + aoff + m * 2048), hi_ = *(const PG8_LAS i32x4*)(lds + PG8_SA(b, h) + aoff + m * 2048 + 1024); dst##8[m] = __builtin_shufflevector(lo_, hi_, 0, 1, 2, 3, 4, 5, 6, 7); } } \
    else { _Pragma("unroll") for (int m = 0; m < 4; ++m) _Pragma("unroll") for (int k = 0; k < 2; ++k) dst[m][k] = *(const PG8_LAS bf16x8*)(lds + PG8_SA(b, h) + aoff + m * 2048 + k * 1024); } } while (0)
#define PG8_LDB(dst, b, h) do { if constexpr (FP8 || (MIXK > 0 && PG8_F8SEL)) { _Pragma("unroll") for (int n = 0; n < 2; ++n) { const i32x4 lo_ = *(const PG8_LAS i32x4*)(lds + PG8_SB(b, h) + boff + n * 2048), hi_ = *(const PG8_LAS i32x4*)(lds + PG8_SB(b, h) + boff + n * 2048 + 1024); dst##8[n] = __builtin_shufflevector(lo_, hi_, 0, 1, 2, 3, 4, 5, 6, 7); } } \
    else { _Pragma("unroll") for (int n = 0; n < 2; ++n) _Pragma("unroll") for (int k = 0; k < 2; ++k) dst[n][k] = *(const PG8_LAS bf16x8*)(lds + PG8_SB(b, h) + boff + n * 2048 + k * 1024); } } while (0)
#define PG8_MMA(ai, bj, At, Bt) do { __builtin_amdgcn_s_setprio(1); _Pragma("unroll") for (int m = 0; m < 4; ++m) _Pragma("unroll") for (int n = 0; n < 2; ++n) { \
        if constexpr (FP8) asm volatile("v_mfma_f32_16x16x128_f8f6f4 %0, %1, %2, %0" : "+v"(acc[ai][bj][m][n]) : "v"(Bt##8[n]), "v"(At##8[m]));     \
        else if constexpr (MIXK > 0 && PG8_F8SEL) asm volatile("v_mfma_scale_f32_16x16x128_f8f6f4 %0, %1, %2, %0, %3, %4 op_sel_hi:[0,0,0]" : "+v"(acc[ai][bj][m][n]) : "v"(Bt##8[n]), "v"(At##8[m]), "v"(sclW_), "v"(sclA_)); \
        else { _Pragma("unroll") for (int k = 0; k < 2; ++k) acc[ai][bj][m][n] = __builtin_amdgcn_mfma_f32_16x16x32_bf16(Bt[n][k], At[m][k], acc[ai][bj][m][n], 0, 0, 0); } } \
        __builtin_amdgcn_s_setprio(0); } while (0)
#define PG8_WAIT_V(n) asm volatile("s_waitcnt vmcnt(" #n ")" ::: "memory")
#define PG8_WAIT_L(n) asm volatile("s_waitcnt lgkmcnt(" #n ")" ::: "memory")
#define PG8_BAR __builtin_amdgcn_s_barrier()
#define PG8_SCHED __builtin_amdgcn_sched_barrier(0)
    Unit cur, nxt; int ui = 0;
    if (!S.next(0, cur)) return;
    f32x4 acc[2][2][4][2];
#pragma unroll
    for (int a = 0; a < 2; ++a)
#pragma unroll
        for (int b = 0; b < 2; ++b)
#pragma unroll
            for (int m = 0; m < 4; ++m)
#pragma unroll
                for (int n = 0; n < 2; ++n) acc[a][b][m][n] = (f32x4){0.f, 0.f, 0.f, 0.f};
    bf16x8 At[4][2], B0[2][2], B1[2][2];
    const int sclW_ = 0x7A7A7A7A, sclA_ = 0x7B7B7B7B;
    i32x8 At8[4], B08[2], B18[2];
    const char* cA = cur.a; const char* cB = cur.b;
    S.a_ready(cur);
    if constexpr (SP2) {
        PG8_STAGE(PG8_SB(0, 0), cB, voffB); PG8_STAGE(PG8_SB(0, 1), cB + hstepB, voffB); PG8_STAGE(PG8_SA(0, 0), cA, voffA); PG8_STAGE(PG8_SA(0, 1), cA + hstepA, voffA);
        if (wr == 1) PG8_BAR;
        PG8_WAIT_V(2); PG8_BAR;
        PG8_STAGE(PG8_SB(1, 0), cB + kstep, voffB); PG8_STAGE(PG8_SA(1, 0), cA + kstep, voffA); PG8_STAGE(PG8_SB(1, 1), cB + hstepB + kstep, voffB);
        PG8_WAIT_V(6); PG8_BAR;
    } else {
        PG8_STAGE(PG8_SB(0, 0), cB, voffB); PG8_STAGE(PG8_SA(0, 0), cA, voffA); PG8_STAGE(PG8_SB(0, 1), cB + hstepB, voffB); PG8_STAGE(PG8_SA(0, 1), cA + hstepA, voffA);
        if (wr == 1) PG8_BAR;
        PG8_WAIT_V(4); PG8_BAR;
        PG8_STAGE(PG8_SB(1, 0), cB + kstep, voffB); PG8_STAGE(PG8_SA(1, 0), cA + kstep, voffA); PG8_STAGE(PG8_SB(1, 1), cB + hstepB + kstep, voffB);
        PG8_WAIT_V(6); PG8_BAR;
    }
    for (;;) {
        const bool has_next = S.next(ui + 1, nxt);
        const char* nA = has_next ? nxt.a : cA; const char* nB = has_next ? nxt.b : cB;
#define PG8_TPTRS(cA, cB, nA, nB) \
            const bool last = (t == nt - 2); \
            const char* a1 = cA + (size_t)(t + 1) * kstep; \
            const char* a2 = last ? nA : cA + (size_t)(t + 2) * kstep; const char* b2 = last ? nB : cB + (size_t)(t + 2) * kstep; \
            const char* a3 = a2 + kstep; const char* b3 = b2 + kstep; \
            if (last && has_next) S.a_ready(nxt);
        if constexpr (MIXK > 0) {
            for (int t = 0; t < MIXK; t += 2) { PG8_TPTRS(cA, cB, nA, nB)
#define PG8_F8SEL false
                PG8_ITER_SP2;
#undef PG8_F8SEL
            }
            const char* cA2 = cA; const char* cB2 = cB; const char* nA2 = nA; const char* nB2 = nB;
            asm volatile("" : "+s"(cA2), "+s"(cB2), "+s"(nA2), "+s"(nB2));
            for (int t = MIXK; t < nt; t += 2) { PG8_TPTRS(cA2, cB2, nA2, nB2)
#define PG8_F8SEL true
                PG8_ITER_SP2;
#undef PG8_F8SEL
            }
        } else
        for (int t = 0; t < nt; t += 2) {
            const bool last = (t == nt - 2);
            const char* a1 = cA + (size_t)(t + 1) * kstep;
            const char* a2 = last ? nA : cA + (size_t)(t + 2) * kstep; const char* b2 = last ? nB : cB + (size_t)(t + 2) * kstep;
            const char* a3 = a2 + kstep; const char* b3 = b2 + kstep;
            if (last && has_next) S.a_ready(nxt);
            if constexpr (SP2) {
#define PG8_F8SEL false
                PG8_ITER_SP2;
#undef PG8_F8SEL
            } else {
#define PG8_F8SEL false
            PG8_LDB(B0, 0, 0); PG8_SCHED; PG8_LDA(At, 0, 0); PG8_STAGE(PG8_SA(1, 1), a1 + hstepA, voffA);
            PG8_WAIT_L(8); PG8_BAR; PG8_WAIT_L(0); PG8_MMA(0, 0, At, B0); PG8_BAR; PG8_SCHED;
            PG8_LDB(B1, 0, 1); PG8_STAGE(PG8_SB(0, 0), b2, voffB);
            PG8_BAR; PG8_WAIT_L(0); PG8_MMA(0, 1, At, B1); PG8_BAR;
            PG8_LDA(At, 0, 1); PG8_STAGE(PG8_SA(0, 0), a2, voffA);
            PG8_BAR; PG8_WAIT_L(0); PG8_MMA(1, 0, At, B0); PG8_BAR; PG8_SCHED;
            PG8_STAGE(PG8_SB(0, 1), b2 + hstepB, voffB);
            PG8_WAIT_V(6); PG8_BAR; PG8_MMA(1, 1, At, B1); PG8_BAR;
            PG8_LDB(B0, 1, 0); PG8_SCHED; PG8_LDA(At, 1, 0); PG8_STAGE(PG8_SA(0, 1), a2 + hstepA, voffA);
            PG8_WAIT_L(8); PG8_BAR; PG8_WAIT_L(0); PG8_MMA(0, 0, At, B0); PG8_BAR; PG8_SCHED;
            PG8_LDB(B1, 1, 1); PG8_STAGE(PG8_SB(1, 0), b3, voffB);
            PG8_BAR; PG8_WAIT_L(0); PG8_MMA(0, 1, At, B1); PG8_BAR;
            PG8_LDA(At, 1, 1); PG8_STAGE(PG8_SA(1, 0), a3, voffA);
            PG8_BAR; PG8_WAIT_L(0); PG8_MMA(1, 0, At, B0); PG8_BAR; PG8_SCHED;
            PG8_STAGE(PG8_SB(1, 1), b3 + hstepB, voffB);
            PG8_WAIT_V(6); PG8_BAR; PG8_MMA(1, 1, At, B1); PG8_BAR;
#undef PG8_F8SEL
            }
        }
        if constexpr (ALIGN_EPI) { if (wr == 0) PG8_BAR; }
        if constexpr (FP8 || MIXK > 0) asm volatile("s_nop 15\n\ts_nop 15" ::: "memory");
        if constexpr (!Epi::AFTER_DRAIN) { E(acc, cur, wr, wc, fr, fq); S.done(cur); }
        if (!has_next) break;
#pragma unroll
        for (int a = 0; a < 2; ++a)
#pragma unroll
            for (int b = 0; b < 2; ++b)
#pragma unroll
                for (int m = 0; m < 4; ++m)
#pragma unroll
                    for (int n = 0; n < 2; ++n) acc[a][b][m][n] = (f32x4){0.f, 0.f, 0.f, 0.f};
        cur = nxt; cA = nA; cB = nB; ++ui;
        if constexpr (ALIGN_EPI) { if (wr == 1) PG8_BAR; }
    }
    PG8_WAIT_V(0);
    if constexpr (!ALIGN_EPI) { if (wr == 0) PG8_BAR; }
    PG8_BAR;
    if constexpr (Epi::AFTER_DRAIN) { E.fused(acc, cur, wr, wc, fr, fq, lds, wid, lane); S.done(cur); }
#undef PG8_SA
#undef PG8_SB
#undef PG8_STAGE
#undef PG8_LDA
#undef PG8_LDB
#undef PG8_MMA
#undef PG8_WAIT_V
#undef PG8_WAIT_L
#undef PG8_BAR
#undef PG8_SCHED
}
}

constexpr int DM = 2048, NBATCH = 4, SEQ = 4096, MTOK = NBATCH * SEQ, DEPTH = 2, NMEM = 256, MMEM = NBATCH * NMEM;
constexpr int D_IN = 7264, LDP = 7424;
constexpr int C_GQ = 0, C_GK = 512, C_GV = 1024, C_GR = 2048, C_DQ = 3072, C_DK = 4096, C_DV = 5120, C_IQ = 6144, C_GZ = 7168, C_IK = 7184, C_IW = 7248;
constexpr int DFF = 5632;
constexpr float EPS = 1e-6f;
constexpr int NWAVES = 8, NTHR = 512;
constexpr int MIXP = 1536; constexpr float FP8_ODSA_SCALE = 16.0f, FP8_WOUT_SCALE = 32.0f;
#ifndef FP8_FFN_OUT
#define FP8_FFN_OUT 3
#endif
#ifndef FP8_LAYERS
#define FP8_LAYERS 3
#endif
#ifndef FP8_INPROJ
#define FP8_INPROJ 3
#endif
#ifndef FP8_IN_T0_L0
#define FP8_IN_T0_L0 12
#endif
#ifndef FP8_IN_T0_L1
#define FP8_IN_T0_L1 4
#endif
#define FP8_IN_T0(l) ((l) == 0 ? FP8_IN_T0_L0 : FP8_IN_T0_L1)
constexpr int FP8_IN_ROWS = 6144; constexpr float FP8_WIN_SCALE = 32.0f;
constexpr float FP8_WFI_SCALE = 32.0f, FP8_WFO_SCALE = 64.0f, FP8_ACT_SCALE = 8.0f;

constexpr size_t MiB = 1u << 20;
constexpr size_t WS_CTL = 0, CTL_ZERO_BYTES = 1 * MiB;
constexpr size_t WS_WIN = 1 * MiB;
constexpr size_t WS_WOUT = WS_WIN + 29 * MiB;
constexpr size_t WS_WXQ = WS_WOUT + 8 * MiB;
constexpr size_t WS_WXKV = WS_WXQ + 8 * MiB;
constexpr size_t WS_WXO = WS_WXKV + 16 * MiB;
constexpr size_t WS_WFI = WS_WXO + 8 * MiB;
constexpr size_t WS_WFO = WS_WFI + 44 * MiB;
constexpr size_t WS_MEMN = WS_WFO + 22 * MiB;
constexpr size_t WS_KV = WS_MEMN + 4 * MiB;
constexpr size_t WS_AT = WS_KV + 8 * MiB;
constexpr size_t WS_BT2 = WS_AT + 16 * MiB;
constexpr size_t WS_PROJ = WS_BT2 + 16 * MiB;
constexpr size_t WS_ACT = WS_PROJ;
constexpr size_t WS_LOGIT = WS_PROJ;
constexpr size_t WS_PROB = WS_PROJ + 64 * MiB;
constexpr size_t WS_BUFA = WS_PROJ + 232 * MiB;
constexpr size_t WS_BUFB = WS_BUFA + 64 * MiB;
constexpr size_t WS_SCR = WS_BUFB;
constexpr size_t WS_PART = WS_BUFB + 128 * MiB;
constexpr size_t WS_DEC = WS_PART + 2 * MiB;
constexpr size_t WS_XB = WS_DEC + 1 * MiB;
constexpr size_t WS_SS = WS_XB + 64 * MiB;
constexpr size_t WS_IKC = WS_SS + 1 * MiB;
constexpr size_t WS_END = WS_IKC + 2 * MiB;
constexpr size_t DO_BCUM = 0, DO_MASK = 32 * MiB, DO_K8 = 40 * MiB, DO_V8T = 56 * MiB, DO_Q8 = 72 * MiB;
static_assert(WS_END <= 700 * MiB, "workspace map");
constexpr int CW_TMO = 0, CW_BAR = 4096, CW_PANEL = 16384;
#ifndef FUSE_SOFTMAX
#define FUSE_SOFTMAX 1
#endif
#ifndef FUSE_NORM
#define FUSE_NORM 0
#endif

constexpr int RING_OFF = 0, RING_BYTES = 131072;
constexpr int LDSCTL_OFF = RING_BYTES, MISC_OFF = LDSCTL_OFF + 320;
constexpr int LDS_BYTES = 147456;

#define RLX_AGENT __ATOMIC_RELAXED, __HIP_MEMORY_SCOPE_AGENT
#define LDS_WAIT() asm volatile("s_waitcnt lgkmcnt(0)" ::: "memory")
#define VM_WAIT() asm volatile("s_waitcnt vmcnt(0)" ::: "memory")
__device__ __forceinline__ unsigned f2bf(float f) { unsigned u = __builtin_bit_cast(unsigned, f); return (u + 0x7fffu + ((u >> 16) & 1u)) >> 16; }
__device__ __forceinline__ unsigned pk2(float lo, float hi) { return f2bf(lo) | (f2bf(hi) << 16); }
__device__ __forceinline__ unsigned pk2h(float lo, float hi) { unsigned r; asm("v_cvt_pk_bf16_f32 %0, %1, %2" : "=v"(r) : "v"(lo), "v"(hi)); return r; }
__device__ __forceinline__ float bf2f(unsigned short b) { return __builtin_bit_cast(float, (unsigned)b << 16); }
__device__ __forceinline__ float bflo(unsigned w) { return __builtin_bit_cast(float, w << 16); }
__device__ __forceinline__ float bfhi(unsigned w) { return __builtin_bit_cast(float, w & 0xffff0000u); }

#define XB_TMO      128
#define XB_XCNT(j)  (256  + 64 * (j))
#define XB_XSUB(j)  (1280 + 64 * (j))
#define XB_XGEN(j)  (2304 + 64 * (j))
#define XB_TOP      3328
#define XB_TOPGEN   3392
#define XCD_BAR_WORDS 3456
#define XB_SPIN_CAP (1u << 18)

__device__ __forceinline__ unsigned xb_ld(unsigned* p)              { return __hip_atomic_load(p, __ATOMIC_RELAXED, __HIP_MEMORY_SCOPE_AGENT); }
__device__ __forceinline__ unsigned xb_add(unsigned* p, unsigned v) { return __hip_atomic_fetch_add(p, v, __ATOMIC_RELAXED, __HIP_MEMORY_SCOPE_AGENT); }
__device__ __forceinline__ unsigned xb_xcc_id() { return (unsigned)__builtin_amdgcn_s_getreg((3 << 11) | 20) & 0xFu; }
#define XB_SPIN(cond, bar) do { unsigned _sp = 0; while (cond) { __builtin_amdgcn_s_sleep(1); \
    if ((++_sp & 255u) == 0u) { if (xb_ld(&(bar)[XB_TMO])) break; if (_sp > XB_SPIN_CAP) { atomicAdd(&(bar)[XB_TMO], 1u); break; } } } } while (0)

struct XcdBarrier {
    unsigned* bar; unsigned x;
    volatile LAS unsigned* st;
};

__device__ __forceinline__ XcdBarrier xcd_barrier_post(unsigned* bar, volatile LAS unsigned* st) {
    XcdBarrier b; b.bar = bar; b.x = xb_xcc_id(); b.st = st;
    if (threadIdx.x == 0) (void)xb_add(&bar[XB_XCNT(b.x)], 1u);
    return b;
}
__device__ __forceinline__ void xcd_barrier_complete(unsigned* bar, unsigned x, unsigned& nloc, unsigned& nx) {
    const unsigned G = gridDim.x * gridDim.y * gridDim.z;
    unsigned sum, cnt, mine, sp = 0u;
    for (;;) {
        sum = 0u; cnt = 0u; mine = 0u;
#pragma unroll
        for (unsigned j = 0; j < 16; ++j) { const unsigned c = xb_ld(&bar[XB_XCNT(j)]); sum += c; cnt += (c > 0u) ? 1u : 0u; mine = (j == x) ? c : mine; }
        if (sum == G) break;
        __builtin_amdgcn_s_sleep(1);
        if ((++sp & 255u) == 0u) { if (xb_ld(&bar[XB_TMO])) break; if (sp > XB_SPIN_CAP) { atomicAdd(&bar[XB_TMO], 1u); break; } }
    }
    nloc = mine > 0u ? mine : 1u; nx = cnt > 0u ? cnt : 1u;
}

__device__ __forceinline__ void xcd_barrier(const XcdBarrier& b) {
    asm volatile("s_waitcnt vmcnt(0)" ::: "memory");
    __syncthreads();
    if (threadIdx.x == 0) {
        unsigned* bar = b.bar;
        __builtin_amdgcn_s_waitcnt(0);
        unsigned nloc = b.st[0], nx = b.st[1];
        if (nloc == 0u) { xcd_barrier_complete(bar, b.x, nloc, nx); b.st[0] = nloc; b.st[1] = nx; }
        const unsigned old = xb_add(&bar[XB_XSUB(b.x)], 1u);
        const unsigned gen = old / nloc;
        if (old + 1u == (gen + 1u) * nloc) {
            __builtin_amdgcn_fence(__ATOMIC_RELEASE, "agent");
            asm volatile("s_waitcnt vmcnt(0)" ::: "memory");
            const unsigned og = xb_add(&bar[XB_TOP], 1u);
            const unsigned tg = og / nx;
            if (og + 1u == (tg + 1u) * nx) xb_add(&bar[XB_TOPGEN], 1u);
            else XB_SPIN(xb_ld(&bar[XB_TOPGEN]) == tg, bar);
            __builtin_amdgcn_fence(__ATOMIC_ACQUIRE, "agent");
            xb_add(&bar[XB_XGEN(b.x)], 1u);
            asm volatile("s_waitcnt vmcnt(0)" ::: "memory");
        } else {
            XB_SPIN(xb_ld(&bar[XB_XGEN(b.x)]) == gen, bar);
            __builtin_amdgcn_fence(__ATOMIC_ACQUIRE, "agent");
            asm volatile("s_waitcnt vmcnt(0)" ::: "memory");
        }
    }
    __syncthreads();
}

struct Frame {
    LAS unsigned char* lds;
    volatile LAS unsigned* MISC;
    gu32* ctl;
    int tid, lane, wave;
    int vcu, G;
    unsigned char* ws;
};
template <int CTRL> __device__ __forceinline__ float dpp_mov(float v) { return __builtin_bit_cast(float, __builtin_amdgcn_update_dpp(0, __builtin_bit_cast(int, v), CTRL, 0xf, 0xf, true)); }
__device__ __forceinline__ float rl(float v, int lane) { return __builtin_bit_cast(float, __builtin_amdgcn_readlane(__builtin_bit_cast(int, v), lane)); }
__device__ __forceinline__ float wave_sum(float v) {
    v += dpp_mov<0xB1>(v); v += dpp_mov<0x4E>(v); v += dpp_mov<0x141>(v); v += dpp_mov<0x140>(v);
    return (rl(v, 0) + rl(v, 16)) + (rl(v, 32) + rl(v, 48));
}
__device__ __forceinline__ float wave_max(float v) {
    v = fmaxf(v, dpp_mov<0xB1>(v)); v = fmaxf(v, dpp_mov<0x4E>(v)); v = fmaxf(v, dpp_mov<0x141>(v)); v = fmaxf(v, dpp_mov<0x140>(v));
    return fmaxf(fmaxf(rl(v, 0), rl(v, 16)), fmaxf(rl(v, 32), rl(v, 48)));
}

template <int MODE> __device__ __forceinline__ int dest_row(int n) {
    if (MODE == 1) { if (n < 2048) return n; if (n < 2064) return C_GZ + (n - 2048); if (n < 7184) return n - 16; if (n < 7248) return C_IK + (n - 7184); return C_IW + (n - 7248); }
    if (MODE == 2) { const int s = n >= DFF ? 1 : 0, j = n - s * DFF; return 256 * (j >> 7) + 128 * s + (j & 127); }
    return n;
}
__device__ __forceinline__ unsigned pk4_fp8(float a, float b, float c2, float d) { unsigned w = 0u; w = __builtin_amdgcn_cvt_pk_fp8_f32(a, b, w, false); w = __builtin_amdgcn_cvt_pk_fp8_f32(c2, d, w, true); return w; }
template <int MODE, bool FP8 = false, bool MIXED = false> __device__ __forceinline__ void p0_transpose_item(const float* W, int K, int N, void* WTv, LAS float* scr, int item, int lane, const float* gk = nullptr, float wscale = 1.0f) {
    const int nblk = N / 32, kb = item / nblk, nb = item % nblk, k0 = 64 * kb, n0 = 32 * nb;
    float wv[32];
#pragma unroll
    for (int i = 0; i < 32; ++i) wv[i] = W[(size_t)(k0 + 2 * i + (lane >> 5)) * N + n0 + (lane & 31)];
#pragma unroll
    for (int i = 0; i < 32; ++i) scr[(2 * i + (lane >> 5)) * 33 + (lane & 31)] = wv[i];
    LDS_WAIT(); asm volatile("" ::: "memory");
    const int c = lane & 7;
    const float ws1 = MIXED ? 1.0f : wscale;
    f32x4 ga = {ws1, ws1, ws1, ws1}, gb = ga;
    if (gk) { ga = *(const f32x4*)(gk + k0 + 8 * c) * ws1; gb = *(const f32x4*)(gk + k0 + 8 * c + 4) * ws1; }
#pragma unroll
    for (int j = 0; j < 4; ++j) { const int n = (lane >> 3) + 8 * j; const LAS float* s = scr + (8 * c) * 33 + n;
        const float v0 = s[0 * 33] * ga.x, v1 = s[1 * 33] * ga.y, v2 = s[2 * 33] * ga.z, v3 = s[3 * 33] * ga.w, v4 = s[4 * 33] * gb.x, v5 = s[5 * 33] * gb.y, v6 = s[6 * 33] * gb.z, v7 = s[7 * 33] * gb.w;
        if constexpr (MIXED) { const int dr = dest_row<MODE>(n0 + n);
            if (dr < FP8_IN_ROWS && dr >= FP8_IN_T0_L1 * 256) { u32x2 o; o.x = pk4_fp8(v0 * wscale, v1 * wscale, v2 * wscale, v3 * wscale); o.y = pk4_fp8(v4 * wscale, v5 * wscale, v6 * wscale, v7 * wscale); *(GAS u32x2*)((unsigned char*)WTv + (size_t)FP8_IN_T0_L1 * 256 * K + (size_t)dr * K + k0 + 8 * c) = o; }
            else { u32x4 o; o.x = pk2h(v0, v1); o.y = pk2h(v2, v3); o.z = pk2h(v4, v5); o.w = pk2h(v6, v7); *(GAS u32x4*)((bf16*)WTv + (size_t)dr * K + k0 + 8 * c) = o; } }
        else if constexpr (FP8) { u32x2 o; o.x = pk4_fp8(v0, v1, v2, v3); o.y = pk4_fp8(v4, v5, v6, v7);
            *(GAS u32x2*)((unsigned char*)WTv + (size_t)dest_row<MODE>(n0 + n) * K + k0 + 8 * c) = o; }
        else { u32x4 o; o.x = pk2h(v0, v1); o.y = pk2h(v2, v3); o.z = pk2h(v4, v5); o.w = pk2h(v6, v7);
            *(GAS u32x4*)((bf16*)WTv + (size_t)dest_row<MODE>(n0 + n) * K + k0 + 8 * c) = o; } }
    LDS_WAIT(); asm volatile("" ::: "memory");
}
__device__ __forceinline__ void rms_row_to_bf16(const float* xrow, const float* g, bf16* orow, int lane) {
    f32x4 v[8]; float s = 0.f;
#pragma unroll
    for (int j = 0; j < 4; ++j) { const float* p = xrow + 8 * lane + 512 * j; v[2 * j] = *(const f32x4*)p; v[2 * j + 1] = *(const f32x4*)(p + 4); }
#pragma unroll
    for (int j = 0; j < 8; ++j) s += (v[j].x * v[j].x + v[j].y * v[j].y) + (v[j].z * v[j].z + v[j].w * v[j].w);
    const float rstd = 1.0f / sqrtf(wave_sum(s) * (1.0f / DM) + EPS);
#pragma unroll
    for (int j = 0; j < 4; ++j) { const float* gp = g + 8 * lane + 512 * j; const f32x4 g0 = *(const f32x4*)gp, g1 = *(const f32x4*)(gp + 4); const f32x4 a = v[2 * j] * rstd * g0, b = v[2 * j + 1] * rstd * g1;
        u32x4 o; o.x = pk2h(a.x, a.y); o.y = pk2h(a.z, a.w); o.z = pk2h(b.x, b.y); o.w = pk2h(b.z, b.w);
        *(u32x4*)(orow + 8 * lane + 512 * j) = o; }
}
struct TDesc { const float* src; const float* gk; unsigned char* dst; int N, K, k0, n0, mode, kind, t0; float wscale; };
__device__ __forceinline__ int dest_row_rt(int mode, int n) { return mode == 1 ? dest_row<1>(n) : (mode == 2 ? dest_row<2>(n) : n); }
__device__ __forceinline__ void t_load(const TDesc& d, f32x4 (&wv)[8], int lane) {
#pragma unroll
    for (int i = 0; i < 8; ++i) wv[i] = __builtin_nontemporal_load((const f32x4*)(d.src + (size_t)(d.k0 + 8 * i + (lane >> 3)) * d.N + d.n0 + 4 * (lane & 7)));
}
__device__ __forceinline__ void t_finish(const TDesc& d, const f32x4 (&wv)[8], LAS float* scr, int lane) {
#pragma unroll
    for (int i = 0; i < 8; ++i) { LAS float* p = scr + (8 * i + (lane >> 3)) * 33 + 4 * (lane & 7); p[0] = wv[i].x; p[1] = wv[i].y; p[2] = wv[i].z; p[3] = wv[i].w; }
    LDS_WAIT(); asm volatile("" ::: "memory");
    const int c = lane & 7, K = d.K, k0 = d.k0;
    const float ws1 = d.kind == 1 ? d.wscale : 1.0f;
    f32x4 ga = {ws1, ws1, ws1, ws1}, gb = ga;
    if (d.gk) { ga = *(const f32x4*)(d.gk + k0 + 8 * c) * ws1; gb = *(const f32x4*)(d.gk + k0 + 8 * c + 4) * ws1; }
#pragma unroll
    for (int j = 0; j < 4; ++j) { const int n = (lane >> 3) + 8 * j; const LAS float* s = scr + (8 * c) * 33 + n;
        const float v0 = s[0 * 33] * ga.x, v1 = s[1 * 33] * ga.y, v2 = s[2 * 33] * ga.z, v3 = s[3 * 33] * ga.w, v4 = s[4 * 33] * gb.x, v5 = s[5 * 33] * gb.y, v6 = s[6 * 33] * gb.z, v7 = s[7 * 33] * gb.w;
        const int dr = dest_row_rt(d.mode, d.n0 + n);
        if (d.kind == 3) {
            if (k0 < 1024) { u32x4 o; o.x = pk2h(v0, v1); o.y = pk2h(v2, v3); o.z = pk2h(v4, v5); o.w = pk2h(v6, v7); *(GAS u32x4*)(d.dst + (size_t)dr * (2 * MIXP) + (size_t)(k0 + 8 * c) * 2) = o; }
            else { const float w = d.wscale; u32x2 o; o.x = pk4_fp8(v0 * w, v1 * w, v2 * w, v3 * w); o.y = pk4_fp8(v4 * w, v5 * w, v6 * w, v7 * w); *(GAS u32x2*)(d.dst + (size_t)dr * (2 * MIXP) + 2048 + (k0 - 1024) + 8 * c) = o; } }
        else if (d.kind == 1) { u32x2 o; o.x = pk4_fp8(v0, v1, v2, v3); o.y = pk4_fp8(v4, v5, v6, v7); *(GAS u32x2*)(d.dst + (size_t)dr * K + k0 + 8 * c) = o; }
        else if (d.kind == 2 && dr < FP8_IN_ROWS && dr >= d.t0 * 256) { const float w = d.wscale; u32x2 o; o.x = pk4_fp8(v0 * w, v1 * w, v2 * w, v3 * w); o.y = pk4_fp8(v4 * w, v5 * w, v6 * w, v7 * w);
            *(GAS u32x2*)(d.dst + (size_t)d.t0 * 256 * K + (size_t)dr * K + k0 + 8 * c) = o; }
        else { u32x4 o; o.x = pk2h(v0, v1); o.y = pk2h(v2, v3); o.z = pk2h(v4, v5); o.w = pk2h(v6, v7); *(GAS u32x4*)((bf16*)d.dst + (size_t)dr * K + k0 + 8 * c) = o; } }
    LDS_WAIT(); asm volatile("" ::: "memory");
}
struct P0Args { const float *x, *mem, *gains, *w_in, *w_out, *w_xq, *w_xkv, *w_xo, *w_fi, *w_fo; unsigned char* ws; int layer, fp8, fp8in, fp8fo; };
__device__ __forceinline__ void p0_prologue(Frame& F, const P0Args& a) {
    LAS float* scr = (LAS float*)(F.lds + RING_OFF + F.wave * 16384);
    int lane_ = threadIdx.x & 63; asm volatile("" : "+v"(lane_));
    const int gw = F.vcu * NWAVES + F.wave, NGW = F.G * NWAVES, lane = lane_;
    unsigned char* ws = a.ws;
    constexpr int I_IN = (DM / 64) * (D_IN / 32), I_SQ = (DM / 64) * (DM / 32), I_KV = (DM / 64) * (2 * DM / 32), I_FI = (DM / 64) * (2 * DFF / 32), I_FO = (DFF / 64) * (DM / 32);
#ifndef REP_P0
#define REP_P0 1
#endif
    for (int rp0_ = 0; rp0_ < REP_P0; ++rp0_) {
        constexpr int E0 = I_FI, E1 = E0 + I_IN, E2 = E1 + I_FO, E3 = E2 + I_KV, E4 = E3 + I_SQ, E5 = E4 + I_SQ;
        auto decode = [&](int it, TDesc& d) {
            int li; d.gk = nullptr; d.wscale = 1.0f; d.mode = 0; d.kind = 0; d.t0 = 0;
            if (it < E0) { li = it; d.src = a.w_fi; d.N = 2 * DFF; d.K = DM; d.dst = ws + WS_WFI; d.mode = 2; d.gk = a.gains + (a.layer * 7 + 4) * DM; if (a.fp8) { d.kind = 1; d.wscale = FP8_WFI_SCALE; } }
            else if (it < E1) { li = it - E0; d.src = a.w_in; d.N = D_IN; d.K = DM; d.dst = ws + WS_WIN; d.mode = 1; d.gk = a.gains + (a.layer * 7 + 0) * DM; if (a.fp8in) { d.kind = 2; d.wscale = FP8_WIN_SCALE; d.t0 = FP8_IN_T0(a.layer); } }
            else if (it < E2) { li = it - E1; d.src = a.w_fo; d.N = DM; d.K = DFF; d.dst = ws + WS_WFO; if (a.fp8fo) { d.kind = 1; d.wscale = FP8_WFO_SCALE; } }
            else if (it < E3) { li = it - E2; d.src = a.w_xkv; d.N = 2 * DM; d.K = DM; d.dst = ws + WS_WXKV; }
            else if (it < E4) { li = it - E3; d.src = a.w_out; d.N = DM; d.K = DM; d.dst = ws + WS_WOUT; d.kind = 3; d.wscale = FP8_WOUT_SCALE; }
            else { li = it - E4; d.src = a.w_xo; d.N = DM; d.K = DM; d.dst = ws + WS_WXO; }
            const int nblk = d.N / 32; d.k0 = 64 * (li / nblk); d.n0 = 32 * (li % nblk); };
        TDesc d0, d1, d2, d3; f32x4 w0[8], w1[8], w2[8], w3[8];
#define P0_TL(k, i) do { const int i_ = (i); if (i_ < E5) { decode(i_, d##k); t_load(d##k, w##k, lane); } } while (0)
        int it = gw;
        P0_TL(0, it); P0_TL(1, it + NGW); P0_TL(2, it + 2 * NGW);
        while (it < E5) {
            P0_TL(3, it + 3 * NGW); t_finish(d0, w0, scr, lane); if (it + NGW >= E5) break;
            P0_TL(0, it + 4 * NGW); t_finish(d1, w1, scr, lane); if (it + 2 * NGW >= E5) break;
            P0_TL(1, it + 5 * NGW); t_finish(d2, w2, scr, lane); if (it + 3 * NGW >= E5) break;
            P0_TL(2, it + 6 * NGW); t_finish(d3, w3, scr, lane); it += 4 * NGW;
        }
#undef P0_TL
    }
    for (int r = gw; r < DM; r += NGW) { const float* src = a.w_xq + (size_t)r * DM; bf16* dst = (bf16*)(ws + WS_WXQ) + (size_t)r * DM;
        const float gr = a.gains[(a.layer * 7 + 2) * DM + r];
#pragma unroll
        for (int j = 0; j < 4; ++j) { const float* p = src + 8 * lane + 512 * j; const f32x4 v0 = *(const f32x4*)p, v1 = *(const f32x4*)(p + 4);
            u32x4 o; o.x = pk2h(v0.x * gr, v0.y * gr); o.y = pk2h(v0.z * gr, v0.w * gr); o.z = pk2h(v1.x * gr, v1.y * gr); o.w = pk2h(v1.z * gr, v1.w * gr); *(u32x4*)(dst + 8 * lane + 512 * j) = o; } }
    for (int r = D_IN + gw; r < LDP; r += NGW) { bf16* dst = (bf16*)(ws + WS_WIN) + (size_t)r * DM;
#pragma unroll
        for (int j = 0; j < 4; ++j) *(u32x4*)(dst + 8 * lane + 512 * j) = (u32x4){0u, 0u, 0u, 0u}; }
    for (int r = gw; r < MMEM; r += NGW) rms_row_to_bf16(a.mem + (size_t)r * DM, a.gains + (a.layer * 7 + 6) * DM, (bf16*)(ws + WS_MEMN) + (size_t)r * DM, lane);
    for (int rp1_ = 0; rp1_ < REP_P0; ++rp1_)
    if (a.layer == 0) for (int r0 = gw; r0 < MTOK; r0 += 2 * NGW) {
        f32x4 xv[2][8]; const bool two = r0 + NGW < MTOK;
#pragma unroll
        for (int q = 0; q < 2; ++q) { const float* xr = a.x + (size_t)((q && two) ? r0 + NGW : r0) * DM;
#pragma unroll
            for (int j = 0; j < 4; ++j) { const float* p = xr + 8 * lane + 512 * j; xv[q][2 * j] = __builtin_nontemporal_load((const f32x4*)p); xv[q][2 * j + 1] = __builtin_nontemporal_load((const f32x4*)(p + 4)); } }
#pragma unroll
        for (int q = 0; q < 2; ++q) { if (q == 1 && !two) break; const int r = r0 + q * NGW; bf16* orow = (bf16*)(ws + WS_XB) + (size_t)r * DM; float s = 0.f;
#pragma unroll
            for (int j = 0; j < 4; ++j) { const f32x4 v0 = xv[q][2 * j], v1 = xv[q][2 * j + 1];
                s += (v0.x * v0.x + v0.y * v0.y) + (v0.z * v0.z + v0.w * v0.w) + (v1.x * v1.x + v1.y * v1.y) + (v1.z * v1.z + v1.w * v1.w);
                u32x4 o; o.x = pk2h(v0.x, v0.y); o.y = pk2h(v0.z, v0.w); o.z = pk2h(v1.x, v1.y); o.w = pk2h(v1.z, v1.w); *(u32x4*)(orow + 8 * lane + 512 * j) = o;
                if (a.fp8in) { u32x2 o8; o8.x = pk4_fp8(v0.x, v0.y, v0.z, v0.w); o8.y = pk4_fp8(v1.x, v1.y, v1.z, v1.w); *(u32x2*)(ws + WS_BUFB + (size_t)r * DM + 8 * lane + 512 * j) = o8; } }
            s = wave_sum(s); if (lane == 0) ((float*)(ws + WS_SS))[r] = s; } }
}

__device__ __forceinline__ void norm_rows(int row_lo, int row_hi, int widx, int nw, bf16* xb, const bf16* y, const float* part, const float* g_post, float* ss, float* outf, unsigned char* xb8) {
    int lane_ = threadIdx.x & 63; asm volatile("" : "+v"(lane_));
    const int gw = row_lo + widx, NGW = nw, lane = lane_, MT = row_hi;
    for (int r0 = gw; r0 < MT; r0 += 2 * NGW) {
        const int r1 = r0 + NGW; const bool two = r1 < MT; const int rb = two ? r1 : r0;
        u32x4 xw[2][4], yw[2][4]; float ps[2];
#pragma unroll
        for (int q = 0; q < 2; ++q) { const int r = q ? rb : r0; ps[q] = lane < 32 ? part[(size_t)r * 32 + lane] : 0.f;
#pragma unroll
            for (int j = 0; j < 4; ++j) { const int c = 8 * lane + 512 * j; xw[q][j] = *(const u32x4*)(xb + (size_t)r * DM + c); yw[q][j] = *(const u32x4*)(y + (size_t)r * DM + c); } }
#pragma unroll
        for (int q = 0; q < 2; ++q) { if (q == 1 && !two) break; const int r = q ? r1 : r0;
            const float rstd1 = 1.0f / sqrtf(wave_sum(ps[q]) * (1.0f / DM) + EPS);
            float s = 0.f;
#pragma unroll
            for (int j = 0; j < 4; ++j) { const int c = 8 * lane + 512 * j; const f32x4 g0 = *(const f32x4*)(g_post + c), g1 = *(const f32x4*)(g_post + c + 4);
                const u32x4 xv = xw[q][j], yv = yw[q][j];
                const f32x4 x0 = {bflo(xv.x), bfhi(xv.x), bflo(xv.y), bfhi(xv.y)}, x1 = {bflo(xv.z), bfhi(xv.z), bflo(xv.w), bfhi(xv.w)};
                const f32x4 y0 = {bflo(yv.x), bfhi(yv.x), bflo(yv.y), bfhi(yv.y)}, y1 = {bflo(yv.z), bfhi(yv.z), bflo(yv.w), bfhi(yv.w)};
                const f32x4 a = x0 + y0 * rstd1 * g0, b = x1 + y1 * rstd1 * g1;
                s += (a.x * a.x + a.y * a.y) + (a.z * a.z + a.w * a.w) + (b.x * b.x + b.y * b.y) + (b.z * b.z + b.w * b.w);
                if (outf) { float* op = outf + (size_t)r * DM + c; *(f32x4*)op = a; *(f32x4*)(op + 4) = b; }
                else { u32x4 o; o.x = pk2h(a.x, a.y); o.y = pk2h(a.z, a.w); o.z = pk2h(b.x, b.y); o.w = pk2h(b.z, b.w); *(u32x4*)(xb + (size_t)r * DM + c) = o; }
                if (xb8) { u32x2 o8; o8.x = pk4_fp8(a.x, a.y, a.z, a.w); o8.y = pk4_fp8(b.x, b.y, b.z, b.w); *(u32x2*)(xb8 + (size_t)r * DM + c) = o8; } }
            s = wave_sum(s); if (lane == 0) ss[r] = s; }
    }
}
__device__ __forceinline__ void norm_phase(Frame& F, bf16* xb, const bf16* y, const float* part, const float* g_post, float* ss, float* outf, unsigned char* xb8 = nullptr) {
    norm_rows(0, MTOK, F.vcu * NWAVES + F.wave, F.G * NWAVES, xb, y, part, g_post, ss, outf, xb8);
}
__device__ __forceinline__ void panel_sync(unsigned* cnt, unsigned* tmo) {
    asm volatile("s_waitcnt vmcnt(0)" ::: "memory");
    __syncthreads();
    if (threadIdx.x == 0) {
        __builtin_amdgcn_fence(__ATOMIC_RELEASE, "agent"); asm volatile("s_waitcnt vmcnt(0)" ::: "memory");
        (void)__hip_atomic_fetch_add(cnt, 1u, __ATOMIC_RELAXED, __HIP_MEMORY_SCOPE_AGENT);
        unsigned sp = 0u;
        while (__hip_atomic_load(cnt, __ATOMIC_RELAXED, __HIP_MEMORY_SCOPE_AGENT) < 4u) { __builtin_amdgcn_s_sleep(1);
            if ((++sp & 255u) == 0u) { if (__hip_atomic_load(tmo, __ATOMIC_RELAXED, __HIP_MEMORY_SCOPE_AGENT)) break; if (sp > (1u << 18)) { atomicAdd(tmo, 1u); break; } } }
        __builtin_amdgcn_fence(__ATOMIC_ACQUIRE, "agent"); asm volatile("s_waitcnt vmcnt(0)" ::: "memory");
    }
    __syncthreads();
}
__device__ __forceinline__ void norm_phase_shadow(Frame& F, const bf16* xb, const bf16* y, const float* part, const float* g_post, float* ss, bf16* xdst) {
    int lane_ = threadIdx.x & 63; asm volatile("" : "+v"(lane_));
    const int gw = F.vcu * NWAVES + F.wave, NGW = F.G * NWAVES, lane = lane_;
    for (int r = gw; r < MTOK; r += NGW) {
        const float ps = lane < 32 ? part[(size_t)r * 32 + lane] : 0.f;
        const float rstd1 = 1.0f / sqrtf(wave_sum(ps) * (1.0f / DM) + EPS);
        float s = 0.f;
#pragma unroll
        for (int j = 0; j < 4; ++j) { const int c = 8 * lane + 512 * j;
            const u32x4 xw = *(const u32x4*)(xb + (size_t)r * DM + c), yw = *(const u32x4*)(y + (size_t)r * DM + c); const f32x4 g0 = *(const f32x4*)(g_post + c), g1 = *(const f32x4*)(g_post + c + 4);
            const f32x4 x0 = {bflo(xw.x), bfhi(xw.x), bflo(xw.y), bfhi(xw.y)}, x1 = {bflo(xw.z), bfhi(xw.z), bflo(xw.w), bfhi(xw.w)};
            const f32x4 y0 = {bflo(yw.x), bfhi(yw.x), bflo(yw.y), bfhi(yw.y)}, y1 = {bflo(yw.z), bfhi(yw.z), bflo(yw.w), bfhi(yw.w)};
            const f32x4 a = x0 + y0 * rstd1 * g0, b = x1 + y1 * rstd1 * g1;
            s += (a.x * a.x + a.y * a.y) + (a.z * a.z + a.w * a.w) + (b.x * b.x + b.y * b.y) + (b.z * b.z + b.w * b.w);
            u32x4 o; o.x = pk2h(a.x, a.y); o.y = pk2h(a.z, a.w); o.z = pk2h(b.x, b.y); o.w = pk2h(b.z, b.w); *(u32x4*)(xdst + (size_t)r * DM + c) = o; }
        s = wave_sum(s); if (lane == 0) ss[r] = s;
    }
}
__device__ __forceinline__ void xsoftmax_phase(Frame& F, const float* logit, bf16* prob, const float* ss) {
    int lane_ = threadIdx.x & 63; asm volatile("" : "+v"(lane_));
    const int gw = F.vcu * NWAVES + F.wave, NGW = F.G * NWAVES, lane = lane_;
    constexpr float C0 = 1.4426950408889634f * 0.04419417382415922f;
    for (int r = gw; r < MTOK; r += NGW) {
        const float C2 = C0 / sqrtf(ss[r] * (1.0f / DM) + EPS);
#pragma unroll
        for (int hd = 0; hd < 4; ++hd) { const f32x4 v = *(const f32x4*)(logit + (size_t)r * 1024 + hd * 256 + 4 * lane);
            const float mx = wave_max(fmaxf(fmaxf(v.x, v.y), fmaxf(v.z, v.w)));
            const float e0 = __builtin_amdgcn_exp2f((v.x - mx) * C2), e1 = __builtin_amdgcn_exp2f((v.y - mx) * C2), e2 = __builtin_amdgcn_exp2f((v.z - mx) * C2), e3 = __builtin_amdgcn_exp2f((v.w - mx) * C2);
            const float inv = 1.0f / wave_sum((e0 + e1) + (e2 + e3));
            u32x2 o; o.x = pk2h(e0 * inv, e1 * inv); o.y = pk2h(e2 * inv, e3 * inv);
            *(u32x2*)(prob + (size_t)r * 1024 + hd * 256 + 4 * lane) = o; }
    }
}
namespace dsa {
using pg8::i32x8; using pg8::i32x4;
constexpr int LDKV = LDP, LDO = 2 * MIXP, BL_OFF = 67584 + 512;
constexpr int D = 128; constexpr float THR = 6.f;
constexpr float SCALE = 0.08838834764831845f;
constexpr int NW = 8, QBLK = 32, KVBLK = 64, QB = NW * QBLK;
constexpr int SHM_V = KVBLK * D * 2, SHM_K = KVBLK * D * 2;
template <class A, class Bt> struct same_t { static constexpr bool v = false; };
template <class A> struct same_t<A, A> { static constexpr bool v = true; };

#define KSWZ(row, colB) ((row) * 256 + ((colB) ^ (((row) & 7) << 4)))
#define SBAR() __builtin_amdgcn_sched_barrier(0)
#define KSWZ8(row, colB) ((row) * 128 + ((colB) ^ (((row) & 7) << 4)))
__device__ __forceinline__ u32x2 bf8_to_e4m3(bf16x8 v) { const u32x4 w = *reinterpret_cast<const u32x4*>(&v);
    u32x2 o; o.x = pk4_fp8(bflo(w.x), bfhi(w.x), bflo(w.y), bfhi(w.y)); o.y = pk4_fp8(bflo(w.z), bfhi(w.z), bflo(w.w), bfhi(w.w)); return o; }
__device__ __forceinline__ int v_st(int k, int c) { const int kk = (k & ~0xC) | ((k & 4) << 1) | ((k & 8) >> 1); return ((kk >> 3) * 4 + (c >> 5)) * 512 + ((kk & 7) * 32 + (c & 31)) * 2; }
__device__ __forceinline__ int v_rd_base(int lane) { return ((lane & 3) << 3) | (((lane >> 2) & 3) << 6) | (((lane >> 4) & 1) << 5) | (((lane >> 5) & 1) << 8); }
constexpr int v_rd_off(int d0, int ks, int half) { return d0 * 512 + ks * 4096 + half * 2048; }
__device__ __forceinline__ int crow(int r, int hi) { return (r & 3) + 8 * (r >> 2) + 4 * hi; }
__device__ __forceinline__ unsigned cvtpk(float lo, float hi) {
    unsigned r; asm volatile("v_cvt_pk_bf16_f32 %0, %1, %2" : "=v"(r) : "v"(lo), "v"(hi)); return r;
}
__device__ __forceinline__ bf16x8 pack8(f32x4 a, f32x4 b) {
    u32x4 w = {cvtpk(a[0], a[1]), cvtpk(a[2], a[3]), cvtpk(b[0], b[1]), cvtpk(b[2], b[3])};
    return *reinterpret_cast<bf16x8*>(&w);
}
template <class T> __device__ __forceinline__ bf16x8 load8(const T* p) {
    if constexpr (same_t<T, float>::v) { return pack8(*(const f32x4*)p, *(const f32x4*)(p + 4)); }
    else { return *reinterpret_cast<const bf16x8*>(p); }
}
__device__ __forceinline__ void dsa_mask_tile(f32x16& p0, f32x16& p1, unsigned long long mw, int hi) {
    const unsigned lo = (unsigned)mw >> (4 * hi), hw = (unsigned)(mw >> 32) >> (4 * hi);
#pragma unroll
    for (int r = 0; r < 16; ++r) {
        const int c = (r & 3) + 8 * (r >> 2);
        const unsigned t0 = (unsigned)__builtin_amdgcn_sbfe((int)lo, c, 1), t1 = (unsigned)__builtin_amdgcn_sbfe((int)hw, c, 1);
        p0[r] = __uint_as_float((__float_as_uint(p0[r]) & t0) | (0xFF800000u & ~t0));
        p1[r] = __uint_as_float((__float_as_uint(p1[r]) & t1) | (0xFF800000u & ~t1));
    }
}
__device__ __forceinline__ void dsa_bias_tile(f32x16& p0, f32x16& p1, int dq, const float* BL) {
#pragma unroll
    for (int r = 0; r < 16; ++r) {
        const int c = (r & 3) + 8 * (r >> 2);
        int d0 = dq - c, d1 = dq - c - 32;
        d0 = d0 < 0 ? 0 : (d0 > 127 ? 127 : d0); d1 = d1 < 0 ? 0 : (d1 > 127 ? 127 : d1);
        p0[r] += BL[d0]; p1[r] += BL[d1];
    }
}
__device__ __forceinline__ void partialSM(f32x16& p0, f32x16& p1, float& m_reg, float& mn, float& alpha) {
    float pmax = p0[0]; for (int r = 1; r < 16; ++r) pmax = fmaxf(pmax, p0[r]); for (int r = 0; r < 16; ++r) pmax = fmaxf(pmax, p1[r]);
    { auto rr = __builtin_amdgcn_permlane32_swap(__float_as_uint(pmax), __float_as_uint(pmax), false, false);
      pmax = fmaxf(__uint_as_float(rr[0]), __uint_as_float(rr[1])); }
    constexpr float C2 = 1.4426950408889634f * SCALE;
    if (__builtin_expect(__all((pmax - m_reg) * SCALE <= THR), 1)) { mn = m_reg; alpha = 1.f; }
    else { mn = fmaxf(m_reg, pmax); alpha = __builtin_amdgcn_exp2f((m_reg - mn) * C2); m_reg = mn; }
    const float mnL = -mn * C2;
    for (int r = 0; r < 16; ++r) p0[r] = fmaf(p0[r], C2, mnL); for (int r = 0; r < 16; ++r) p1[r] = fmaf(p1[r], C2, mnL);
    for (int r = 0; r < 16; ++r) p0[r] = __builtin_amdgcn_exp2f(p0[r]);
}
__device__ __forceinline__ void finishSM(f32x16& p0, f32x16& p1, float alpha, float& l_reg, bf16x8& pa0, bf16x8& pa1, bf16x8& pa2, bf16x8& pa3) {
    for (int r = 0; r < 16; ++r) p1[r] = __builtin_amdgcn_exp2f(p1[r]);
    float ps = 0; for (int r = 0; r < 16; ++r) ps += p0[r]; for (int r = 0; r < 16; ++r) ps += p1[r];
    { auto rr = __builtin_amdgcn_permlane32_swap(__float_as_uint(ps), __float_as_uint(ps), false, false);
      ps = __uint_as_float(rr[0]) + __uint_as_float(rr[1]); }
    l_reg = l_reg * alpha + ps;
#define PK4(P, B_, OUT) do { unsigned a0 = cvtpk(P[B_+0], P[B_+1]), a1 = cvtpk(P[B_+2], P[B_+3]);                          \
        unsigned b0 = cvtpk(P[B_+4], P[B_+5]), b1 = cvtpk(P[B_+6], P[B_+7]);                                             \
        auto r0 = __builtin_amdgcn_permlane32_swap(a0, b0, false, false); auto r1 = __builtin_amdgcn_permlane32_swap(a1, b1, false, false); \
        u32x4 w = {r0[0], r1[0], r0[1], r1[1]}; OUT = *reinterpret_cast<bf16x8*>(&w); } while (0)
    PK4(p0, 0, pa0); PK4(p0, 8, pa1); PK4(p1, 0, pa2); PK4(p1, 8, pa3);
#undef PK4
}
template <int KB, bool SK>
__device__ __forceinline__ void qkt(f32x16& p0, f32x16& p1, const char* K_lds, int r32, int hi, const bf16x8* qr, bool act) {
    if (SK && !act) { const float NEG = -__builtin_inff();
#pragma unroll
        for (int r = 0; r < 16; ++r) { p0[r] = NEG; p1[r] = NEG; } return; }
    p0 = f32x16{}; p1 = f32x16{};
    const char* kb[4];
#pragma unroll
    for (int dd = 0; dd < 4; ++dd) kb[dd] = K_lds + KB * SHM_K + KSWZ(r32, (dd * 16 + hi * 8) * 2);
#pragma unroll
    for (int d0 = 0; d0 < 8; ++d0) { const char* a = kb[d0 & 3] + (d0 >> 2) * 128;
        bf16x8 b0 = *reinterpret_cast<const bf16x8*>(a);
        bf16x8 b1 = *reinterpret_cast<const bf16x8*>(a + 32 * 256);
        p0 = __builtin_amdgcn_mfma_f32_32x32x16_bf16(b0, qr[d0], p0, 0, 0, 0);
        p1 = __builtin_amdgcn_mfma_f32_32x32x16_bf16(b1, qr[d0], p1, 0, 0, 0); }
}
template <int KB, bool SK>
__device__ __forceinline__ void qkt8(f32x16& p0, f32x16& p1, const char* K_lds, int r32, int hi, const i32x8* q8, bool act) {
    if (SK && !act) { const float NEG = -__builtin_inff();
#pragma unroll
        for (int r = 0; r < 16; ++r) { p0[r] = NEG; p1[r] = NEG; } return; }
    const char* kb = K_lds + KB * SHM_K + r32 * 128; const int sw = r32 & 7;
#pragma unroll
    for (int m = 0; m < 2; ++m) {
        const char* c0 = kb + (((4 * m + 2 * hi) ^ sw) << 4); const char* c1 = kb + (((4 * m + 2 * hi + 1) ^ sw) << 4);
        const i32x4 a0 = *reinterpret_cast<const i32x4*>(c0), a1 = *reinterpret_cast<const i32x4*>(c1), b0 = *reinterpret_cast<const i32x4*>(c0 + 32 * 128), b1 = *reinterpret_cast<const i32x4*>(c1 + 32 * 128);
        const i32x8 ka = __builtin_shufflevector(a0, a1, 0, 1, 2, 3, 4, 5, 6, 7), kc = __builtin_shufflevector(b0, b1, 0, 1, 2, 3, 4, 5, 6, 7);
        if (m == 0) { asm volatile("v_mfma_f32_32x32x64_f8f6f4 %0, %1, %2, 0" : "=&v"(p0) : "v"(ka), "v"(q8[0])); asm volatile("v_mfma_f32_32x32x64_f8f6f4 %0, %1, %2, 0" : "=&v"(p1) : "v"(kc), "v"(q8[0])); }
        else { asm volatile("v_mfma_f32_32x32x64_f8f6f4 %0, %1, %2, %0" : "+v"(p0) : "v"(ka), "v"(q8[1])); asm volatile("v_mfma_f32_32x32x64_f8f6f4 %0, %1, %2, %0" : "+v"(p1) : "v"(kc), "v"(q8[1])); } }
    asm volatile("s_nop 15\n\ts_nop 3" : "+v"(p0), "+v"(p1));
}
template <int VB, bool SK>
__device__ __forceinline__ void pv_tile(f32x16* o, int vb0, bf16x8 pa0, bf16x8 pa1, bf16x8 pa2, bf16x8 pa3, bool act) {
    if (SK && !act) return;
#define TRRD(dst, off) asm volatile("ds_read_b64_tr_b16 %0, %1 offset:%2" : "=&v"(dst) : "v"(vb0), "i"(off) : "memory")
#define PV_D0(d0) do { s16x4 l0, l1, l2, l3, h0, h1, h2, h3; constexpr int b_ = VB * SHM_V + v_rd_off(d0, 0, 0);     \
        TRRD(l0, b_); TRRD(h0, b_ + 2048); TRRD(l1, b_ + 4096); TRRD(h1, b_ + 6144); TRRD(l2, b_ + 8192); TRRD(h2, b_ + 10240); TRRD(l3, b_ + 12288); TRRD(h3, b_ + 14336); \
        asm volatile("s_waitcnt lgkmcnt(0)" ::: "memory"); SBAR();                 \
        o[d0] = __builtin_amdgcn_mfma_f32_32x32x16_bf16(pa0, (bf16x8){l0[0], l0[1], l0[2], l0[3], h0[0], h0[1], h0[2], h0[3]}, o[d0], 0, 0, 0);   \
        o[d0] = __builtin_amdgcn_mfma_f32_32x32x16_bf16(pa1, (bf16x8){l1[0], l1[1], l1[2], l1[3], h1[0], h1[1], h1[2], h1[3]}, o[d0], 0, 0, 0);   \
        o[d0] = __builtin_amdgcn_mfma_f32_32x32x16_bf16(pa2, (bf16x8){l2[0], l2[1], l2[2], l2[3], h2[0], h2[1], h2[2], h2[3]}, o[d0], 0, 0, 0);   \
        o[d0] = __builtin_amdgcn_mfma_f32_32x32x16_bf16(pa3, (bf16x8){l3[0], l3[1], l3[2], l3[3], h3[0], h3[1], h3[2], h3[3]}, o[d0], 0, 0, 0); } while (0)
    PV_D0(0); PV_D0(1); PV_D0(2); PV_D0(3);
#undef PV_D0
#undef TRRD
}

__device__ __forceinline__ void finishSM8(f32x16& p0, f32x16& p1, float alpha, float& l_reg, i32x8& pa) {
    for (int r = 0; r < 16; ++r) p1[r] = __builtin_amdgcn_exp2f(p1[r]);
    float ps = 0; for (int r = 0; r < 16; ++r) ps += p0[r]; for (int r = 0; r < 16; ++r) ps += p1[r];
    { auto rr = __builtin_amdgcn_permlane32_swap(__float_as_uint(ps), __float_as_uint(ps), false, false);
      ps = __uint_as_float(rr[0]) + __uint_as_float(rr[1]); }
    l_reg = l_reg * alpha + ps;
#pragma unroll
    for (int d = 0; d < 4; ++d) { pa[d] = (int)pk4_fp8(p0[4 * d], p0[4 * d + 1], p0[4 * d + 2], p0[4 * d + 3]); pa[4 + d] = (int)pk4_fp8(p1[4 * d], p1[4 * d + 1], p1[4 * d + 2], p1[4 * d + 3]); }
}
__device__ __forceinline__ int vt8_off(int d, int chunk) { return d * 64 + ((chunk ^ (((d >> 2) & 1) << 1)) << 4); }
template <int VB, bool SK>
__device__ __forceinline__ void pv_tile8(f32x16* o, const char* vrd, i32x8 pa, bool act) {
    if (SK && !act) return;
#pragma unroll
    for (int d0 = 0; d0 < 4; ++d0) { const char* vp = vrd + VB * SHM_V + d0 * 2048;
        const i32x4 lo_ = *reinterpret_cast<const i32x4*>(vp), hi_ = *reinterpret_cast<const i32x4*>(vp + 16);
        const i32x8 vb = __builtin_shufflevector(lo_, hi_, 0, 1, 2, 3, 4, 5, 6, 7);
        asm volatile("v_mfma_f32_32x32x64_f8f6f4 %0, %1, %2, %0" : "+v"(o[d0]) : "v"(pa), "v"(vb)); }
    asm volatile("s_nop 15\n\ts_nop 3" : "+v"(o[0]), "+v"(o[1]), "+v"(o[2]), "+v"(o[3]));
}

template <class TIn, class TOut> struct BlockRef { const TIn* Q; const TIn* K; const TIn* V; TOut* O; const unsigned long long* MK; int P0; const unsigned char* K8; const unsigned char* V8; const unsigned char* Q8; };
template <class TIn> struct Seam {
    bf16x8 qr[8];
    i32x8 q8[2];
    bf16x8 st_v0, st_v1, st_k0, st_k1; u32x2 sk0, sk1; u32x4 sv; f32x4 sf0, sf1, sf2, sf3;
    f32x4 tq[16];
};
#define ROW(p, k0, rr) ((p) + (size_t)((k0) + (rr)) * LDKV + sc)
#define VMW() asm volatile("s_waitcnt vmcnt(0)" ::: "memory")
#define VMWN(n) asm volatile("s_waitcnt vmcnt(%0)" :: "i"(n) : "memory")
#define SLOAD_H(Kp, Vp, k0) do { S.sv = *(const u32x4*)((Vp) + (size_t)vd * 4096 + (k0) + 16 * vkc);                 \
                         S.sk0 = *(const u32x2*)((Kp) + (size_t)((k0) + sr) * 1024 + sc); S.sk1 = *(const u32x2*)((Kp) + (size_t)((k0) + 32 + sr) * 1024 + sc); } while (0)
#define SWRITE_HK(bf) do { *(u32x2*)(K_lds + (bf) * SHM_K + kws) = S.sk0; *(u32x2*)(K_lds + (bf) * SHM_K + kws + 32 * 128) = S.sk1; } while (0)
#define SWRITE_HV(bf) do { *(u32x2*)(V_lds + (bf) * SHM_V + vwr0) = (u32x2){S.sv.x, S.sv.z}; *(u32x2*)(V_lds + (bf) * SHM_V + vwr1) = (u32x2){S.sv.y, S.sv.w}; } while (0)
#define SWRITE_H(bf) do { SWRITE_HV(bf); SWRITE_HK(bf); } while (0)
#define SLOAD_F(p, k0) do { S.sf0 = *(const f32x4*)ROW(p, k0, sr); S.sf1 = *(const f32x4*)(ROW(p, k0, sr) + 4);                \
                            S.sf2 = *(const f32x4*)ROW(p, k0, 32 + sr); S.sf3 = *(const f32x4*)(ROW(p, k0, 32 + sr) + 4); } while (0)
#define SWRITE_KF(bf) do { *(bf16x8*)(K_lds + (bf) * SHM_K + kws) = pack8(S.sf0, S.sf1); *(bf16x8*)(K_lds + (bf) * SHM_K + kws + 32 * 256) = pack8(S.sf2, S.sf3); } while (0)
#define SWRITE_VF(bf) do { *(bf16x8*)(V_lds + (bf) * SHM_V + vst0) = pack8(S.sf0, S.sf1); *(bf16x8*)(V_lds + (bf) * SHM_V + vst1) = pack8(S.sf2, S.sf3); } while (0)
template <class TIn, class TOut>
__device__ __forceinline__ void causal_swa_prime(const BlockRef<TIn, TOut>& cur, char* lds, Seam<TIn>& S) {
    constexpr bool F32 = same_t<TIn, float>::v;
    int tid_ = threadIdx.x; asm volatile("" : "+v"(tid_));
    const int tid = tid_, wid = __builtin_amdgcn_readfirstlane(tid >> 6), lane = tid & 63, r32 = lane & 31, hi = lane >> 5;
    const int sr = tid >> 4, sc = (tid & 15) * 8, kws = KSWZ8(sr, sc), vd = tid >> 2, vkc = tid & 3; char* K_lds = lds + 2 * SHM_V;
    const int kb0 = 0;
#define QLOAD8(QP) { _Pragma("unroll") for (int m_ = 0; m_ < 2; ++m_) { const unsigned char* qp_ = (QP) + (size_t)(wid * QBLK + r32) * 1024 + 64 * m_ + 32 * hi; const i32x4 lo_ = *(const i32x4*)qp_, hi_ = *(const i32x4*)(qp_ + 16); S.q8[m_] = __builtin_shufflevector(lo_, hi_, 0, 1, 2, 3, 4, 5, 6, 7); } }
    QLOAD8(cur.Q8);
    if constexpr (F32) { SLOAD_F((const float*)cur.K, kb0); VMW(); SWRITE_KF(0); SBAR(); SLOAD_F((const float*)cur.V, kb0); }
    else { SLOAD_H(cur.K8, cur.V8, kb0); VMW(); SWRITE_HK(0); }
    __syncthreads();
}
template <class TIn, class TOut>
__device__ __forceinline__ void causal_swa_block(const BlockRef<TIn, TOut>& cur, const BlockRef<TIn, TOut>& nxt, int skv, char* lds, Seam<TIn>& S) {
    constexpr bool F32 = same_t<TIn, float>::v;
    int tid_ = threadIdx.x; asm volatile("" : "+v"(tid_));
    const int tid = tid_, wid = __builtin_amdgcn_readfirstlane(tid >> 6), lane = tid & 63, r32 = lane & 31, hi = lane >> 5;
    const int j_lo = 0;
    int j_hi = (cur.P0 + QB - 1) / KVBLK + 1; if (j_hi > skv / KVBLK) j_hi = skv / KVBLK;
    const int NT = j_hi - j_lo;
    const int kbn = 0;
    const int qlo = cur.P0 + wid * QBLK, qm = qlo + r32 - 4 * hi;
    const unsigned long long* MK = cur.MK + (size_t)(wid * QBLK + r32) * 64; const float* BLp = (const float*)(lds + BL_OFF);
    unsigned long long mwA = MK[0], mwB = MK[1], mwN = 0ull;
    char* V_lds = lds; char* K_lds = lds + 2 * SHM_V;
    float* ws = (float*)(lds + 2 * SHM_V + 2 * SHM_K) + wid * 64; float* li_l = ws, * al_l = ws + 32;
    float m_reg = -1e30f, l_reg = 0; f32x16 o[4] = {};
    const int sr = tid >> 4, sc = (tid & 15) * 8, kws = KSWZ8(sr, sc);
    const int vd = tid >> 2, vkc = tid & 3, vwr0 = vt8_off(vd, vkc >> 1) + 8 * (vkc & 1), vwr1 = vt8_off(vd, 2 + (vkc >> 1)) + 8 * (vkc & 1);
    constexpr int vst0 = 0, vst1 = 0;
    const char* vrd = V_lds + vt8_off(r32, 2 * hi);
    const TIn* Kh = cur.K; const unsigned char* Vh = cur.V8; const unsigned char* Kh8 = cur.K8; (void)Kh;
#define RESC(a) do { if (__any((a) < 1.f)) { if (hi == 0) al_l[r32] = (a); asm volatile("s_waitcnt lgkmcnt(0)" ::: "memory");              \
                     for (int d_ = 0; d_ < 4; ++d_) for (int r = 0; r < 16; ++r) o[d_][r] *= al_l[crow(r, hi)]; } } while (0)
#define KBASE(t) ((j_lo + (t)) * KVBLK)
#define ACT(t) (KBASE(t) <= qlo + QBLK - 1)
#define MASKT(P0_, P1_, t, MW_) do { const int kb_ = KBASE(t); if (kb_ + 176 > qlo) dsa_bias_tile(P0_, P1_, qm - kb_, BLp); dsa_mask_tile(P0_, P1_, MW_, hi); } while (0)
    constexpr int NQL = F32 ? 16 : 4;
    constexpr bool SK = true;
#define SEAM_K0() do { VMWN(NQL); if constexpr (F32) { SWRITE_KF(0); SBAR(); SLOAD_F((const float*)nxt.V, kbn); } else { SWRITE_HK(0); } SBAR(); } while (0)
    f32x16 pA0, pA1, pB0, pB1; float mnA, mnB, alA, alB; i32x8 pa8;
    if constexpr (F32) { VMW(); SWRITE_VF(0); SBAR(); } else { SWRITE_HV(0); SBAR(); }
    if (NT > 1) { if constexpr (F32) SLOAD_F((const float*)Kh, KBASE(1)); else SLOAD_H(Kh8, Vh, KBASE(1)); }
    SBAR(); qkt8<0, SK>(pA0, pA1, K_lds, r32, hi, S.q8, ACT(0));
    if constexpr (F32) { if (NT > 1) { VMW(); SWRITE_KF(1); SBAR(); SLOAD_F((const float*)Vh, KBASE(1)); } }
    MASKT(pA0, pA1, 0, mwA); if (NT > 2) mwA = MK[2]; partialSM(pA0, pA1, m_reg, mnA, alA);
    if (NT > 1) { VMW(); if constexpr (F32) { SWRITE_VF(1); SBAR(); if (NT > 2) SLOAD_F((const float*)Kh, KBASE(2)); } else SWRITE_H(1); }
    __syncthreads();
#define HALF_STEP(PX0, PX1, mnX, alX, PY0, PY1, alY, t, KB, VB, SB, MWX) do {                                                      \
        SBAR(); qkt8<KB, SK>(PX0, PX1, K_lds, r32, hi, S.q8, ACT(t));                                           \
        finishSM8(PY0, PY1, alY, l_reg, pa8); SBAR();                                                         \
        if ((t) + 1 < NT) { if constexpr (F32) { VMW(); SWRITE_KF(SB); SBAR(); SLOAD_F((const float*)Vh, KBASE((t) + 1)); }  \
                            else { SLOAD_H(Kh8, Vh, KBASE((t) + 1)); } if ((t) + 2 < NT) mwN = MK[(t) + 2]; SBAR(); }                                               \
        pv_tile8<VB, SK>(o, vrd, pa8, ACT((t) - 1)); MASKT(PX0, PX1, (t), MWX); partialSM(PX0, PX1, m_reg, mnX, alX);                                        \
        __syncthreads();                                                                                                      \
        if ((t) + 1 < NT) { VMW(); if constexpr (F32) { SWRITE_VF(SB); SBAR(); if ((t) + 2 < NT) SLOAD_F((const float*)Kh, KBASE((t) + 2)); } \
                            else { SWRITE_H(SB); } }                                                                          \
        MWX = mwN;     \
        RESC(alX); __syncthreads(); } while (0)
    for (int t = 1; t + 1 < NT; t += 2) {
        HALF_STEP(pB0, pB1, mnB, alB, pA0, pA1, alA, t, 1, 0, 0, mwB);
        HALF_STEP(pA0, pA1, mnA, alA, pB0, pB1, alB, t + 1, 0, 1, 1, mwA);
    }
    const bool even = (NT & 1) == 0;
    if (even) { SBAR(); qkt8<1, SK>(pB0, pB1, K_lds, r32, hi, S.q8, ACT(NT - 1)); SBAR(); }
#define QROW(e) (nxt.Q + (size_t)(wid * QBLK + r32) * LDKV + ((e) >> 1) * 16 + hi * 8 + ((e) & 1) * 4)
    if constexpr (F32) { SLOAD_F((const float*)nxt.K, kbn); SBAR();
#pragma unroll
        for (int e = 0; e < 8; ++e) S.tq[e] = *(const f32x4*)QROW(e); }
    else { SLOAD_H(nxt.K8, nxt.V8, kbn); SBAR();
        QLOAD8(nxt.Q8); }
    SBAR();
    finishSM8(pA0, pA1, alA, l_reg, pa8); SBAR();
    if constexpr (F32) {
#pragma unroll
        for (int e = 8; e < 16; ++e) S.tq[e] = *(const f32x4*)QROW(e); SBAR(); }
#undef QROW
    pv_tile8<0, SK>(o, vrd, pa8, ACT(even ? NT - 2 : NT - 1));
    if (even) { MASKT(pB0, pB1, NT - 1, mwB); partialSM(pB0, pB1, m_reg, mnB, alB); __syncthreads(); RESC(alB);
        finishSM8(pB0, pB1, alB, l_reg, pa8); SBAR(); pv_tile8<1, SK>(o, vrd, pa8, ACT(NT - 1)); }
    SBAR(); SEAM_K0();
    if (hi == 0) li_l[r32] = l_reg; asm volatile("s_waitcnt lgkmcnt(0)" ::: "memory");
    float rli[16];
#pragma unroll
    for (int r = 0; r < 16; ++r) rli[r] = __builtin_amdgcn_rcpf(li_l[crow(r, hi)]);
    TOut* Ow = cur.O + (size_t)(wid * QBLK) * LDO;
#pragma unroll
    for (int r = 0; r < 16; ++r) { const int orow = crow(r, hi);
#pragma unroll
        for (int d0 = 0; d0 < 4; ++d0) { const float v = o[d0][r] * rli[r];
            if constexpr (same_t<TOut, float>::v) { Ow[(size_t)orow * LDO + d0 * 32 + r32] = v; }
            else if constexpr (same_t<TOut, unsigned char>::v) { Ow[(size_t)orow * LDO + d0 * 32 + r32] = (unsigned char)(__builtin_amdgcn_cvt_pk_fp8_f32(v * FP8_ODSA_SCALE, 0.0f, 0u, false) & 0xffu); }
            else { const float vn = __shfl_xor(v, 1);
                   if ((r32 & 1) == 0) *(unsigned*)(Ow + (size_t)orow * LDO + d0 * 32 + r32) = cvtpk(v, vn); } } }
    if constexpr (F32) {
#pragma unroll
        for (int d0 = 0; d0 < 8; ++d0) S.qr[d0] = pack8(S.tq[2 * d0], S.tq[2 * d0 + 1]); }
    __syncthreads();
#undef RESC
#undef KBASE
#undef ACT
#undef MASKT
#undef SEAM_K0
#undef HALF_STEP
}
#undef ROW
#undef VMW
#undef VMWN
#undef SLOAD_H
#undef SWRITE_HK
#undef SWRITE_HV
#undef SWRITE_H
#undef SLOAD_F
#undef SWRITE_KF
#undef SWRITE_VF

}
#define MFMA16(a, b, c) __builtin_amdgcn_mfma_f32_16x16x32_bf16((a), (b), (c), 0, 0, 0)
#define MFMA32(a, b, c) __builtin_amdgcn_mfma_f32_32x32x16_bf16((a), (b), (c), 0, 0, 0)

constexpr int GL_Z = 0, GL_GT = 4096, GL_RS = 6144, GL_KST = 8192, GL_QD = 8192, GL_KI = 25600, GL_AM = 43008, GL_VS = 53248;
struct GlaArgs { const bf16* proj; const float* w2; const float* bg; const float* ghead; bf16* state; float* dec; float* bcum; bf16* mixcat; };

__device__ __forceinline__ unsigned gla_off_b(unsigned row, unsigned ch) { return 256u * row + 16u * (ch ^ (((row & 3u) << 2) | ((row >> 2) & 3u))); }
__device__ __forceinline__ unsigned gla_tr_addr(unsigned lane, unsigned cc, unsigned t) {
    const unsigned g = lane >> 4, q = (lane & 15u) >> 2, p = lane & 3u;
    return gla_off_b(8u * g + 4u * t + q, 2u * cc + (p >> 1)) + 8u * (p & 1u);
}
#define GLA_TRRD(dst, addr) asm volatile("ds_read_b64_tr_b16 %0, %1" : "=&v"(dst) : "v"(addr) : "memory")
__device__ __forceinline__ bf16x8 gla_vfrag(unsigned vs, unsigned lane, int ks, int vt) {
    const unsigned base = vs + (unsigned)((ks * 2 + (vt >> 3)) * 8192);
    s16x4 lo, hi; const unsigned a0 = base + gla_tr_addr(lane, (unsigned)(vt & 7), 0u), a1 = base + gla_tr_addr(lane, (unsigned)(vt & 7), 1u);
    asm volatile("ds_read_b64_tr_b16 %0, %2\n\tds_read_b64_tr_b16 %1, %3\n\ts_waitcnt lgkmcnt(0)" : "=&v"(lo), "=&v"(hi) : "v"(a0), "v"(a1) : "memory");
    return (bf16x8){lo[0], lo[1], lo[2], lo[3], hi[0], hi[1], hi[2], hi[3]};
}
__device__ __forceinline__ void gla_vfrag2(unsigned vs, unsigned lane, int vt, bf16x8& f0, bf16x8& f1) {
    const unsigned b0 = vs + (unsigned)((vt >> 3) * 8192), b1 = b0 + 16384u, o0 = gla_tr_addr(lane, (unsigned)(vt & 7), 0u), o1 = gla_tr_addr(lane, (unsigned)(vt & 7), 1u);
    s16x4 l0, h0, l1, h1; const unsigned a0 = b0 + o0, a1 = b0 + o1, a2 = b1 + o0, a3 = b1 + o1;
    asm volatile("ds_read_b64_tr_b16 %0, %4\n\tds_read_b64_tr_b16 %1, %5\n\tds_read_b64_tr_b16 %2, %6\n\tds_read_b64_tr_b16 %3, %7\n\ts_waitcnt lgkmcnt(0)"
                 : "=&v"(l0), "=&v"(h0), "=&v"(l1), "=&v"(h1) : "v"(a0), "v"(a1), "v"(a2), "v"(a3) : "memory");
    f0 = (bf16x8){l0[0], l0[1], l0[2], l0[3], h0[0], h0[1], h0[2], h0[3]}; f1 = (bf16x8){l1[0], l1[1], l1[2], l1[3], h1[0], h1[1], h1[2], h1[3]};
}
__device__ __forceinline__ void gla_a_unit(Frame& F, const GlaArgs& a, int b, int n, int h) {
    int tid = threadIdx.x; asm volatile("" : "+v"(tid));
    const int lane = tid & 63, wave = F.wave, fr = lane & 15, fq = lane >> 4, d = tid & 127, cg = tid >> 7;
    LAS float* Z = (LAS float*)(F.lds + GL_Z); LAS float* GT = (LAS float*)(F.lds + GL_GT); LAS bf16* KST = (LAS bf16*)(F.lds + GL_KST);
    const unsigned vs = (unsigned)(uintptr_t)(F.lds + GL_VS);
    const int tok0 = b * SEQ + n * 64, bh = b * 4 + h;
    const bf16* P = a.proj + (size_t)tok0 * LDP;
    u32x4 zw = {0u, 0u, 0u, 0u}; if (tid < 128) zw = *(const u32x4*)(P + (size_t)(tid >> 1) * LDP + C_GZ + (tid & 1) * 8);
    u32x4 vw[4];
#pragma unroll
    for (int i = 0; i < 4; ++i) { const int id = tid + 512 * i; vw[i] = *(const u32x4*)(P + (size_t)(id >> 5) * LDP + C_GV + h * 256 + (id & 31) * 8); }
    float w2[16];
#pragma unroll
    for (int r = 0; r < 16; ++r) w2[r] = a.w2[r * 512 + h * 128 + d];
    const float bias = a.bg[h * 128 + d];
    unsigned short kraw[16];
#pragma unroll
    for (int cc = 0; cc < 16; ++cc) kraw[cc] = P[(size_t)(cg * 16 + cc) * LDP + C_GK + h * 128 + d];
    if (tid < 128) { LAS float* z = Z + (tid >> 1) * 16 + (tid & 1) * 8;
        z[0] = bflo(zw.x); z[1] = bfhi(zw.x); z[2] = bflo(zw.y); z[3] = bfhi(zw.y); z[4] = bflo(zw.z); z[5] = bfhi(zw.z); z[6] = bflo(zw.w); z[7] = bfhi(zw.w); }
#pragma unroll
    for (int i = 0; i < 4; ++i) { const int id = tid + 512 * i, c = id >> 5, ch32 = id & 31;
        *(LAS u32x4*)(F.lds + GL_VS + ((c >> 5) * 2 + (ch32 >> 4)) * 8192 + gla_off_b((unsigned)(c & 31), (unsigned)(ch32 & 15))) = vw[i]; }
    __syncthreads();
    float bc[16]; float run = 0.f;
#pragma unroll
    for (int cc = 0; cc < 16; ++cc) { const int c = cg * 16 + cc; float acc = bias;
#pragma unroll
        for (int r4 = 0; r4 < 4; ++r4) { const f32x4 z = *(LAS f32x4*)(Z + c * 16 + r4 * 4); acc += z.x * w2[r4 * 4] + z.y * w2[r4 * 4 + 1] + z.z * w2[r4 * 4 + 2] + z.w * w2[r4 * 4 + 3]; }
        const float ls = fminf(acc, 0.f) - __logf(1.0f + __expf(-fabsf(acc)));
        run += ls * (1.0f / 16.0f); bc[cc] = run; }
    GT[cg * 128 + d] = run;
    __syncthreads();
    float off = 0.f, blast = 0.f;
#pragma unroll
    for (int g = 0; g < 4; ++g) { const float t = GT[g * 128 + d]; if (g < cg) off += t; blast += t; }
    float* BC = a.bcum + ((size_t)(bh * 64 + n) * 64 + cg * 16) * 128 + d;
    unsigned pk[8];
#pragma unroll
    for (int cc = 0; cc < 16; cc += 2) { const float b0 = bc[cc] + off, b1 = bc[cc + 1] + off;
        BC[cc * 128] = b0; BC[(cc + 1) * 128] = b1;
        pk[cc >> 1] = pk2(bf2f(kraw[cc]) * __expf(blast - b0), bf2f(kraw[cc + 1]) * __expf(blast - b1)); }
    *(LAS u32x4*)(KST + d * 72 + cg * 16) = (u32x4){pk[0], pk[1], pk[2], pk[3]};
    *(LAS u32x4*)(KST + d * 72 + cg * 16 + 8) = (u32x4){pk[4], pk[5], pk[6], pk[7]};
    if (cg == 0) a.dec[(size_t)(bh * 64 + n) * 128 + d] = __expf(blast);
    __syncthreads();
    bf16x8 af[2];
#pragma unroll
    for (int s = 0; s < 2; ++s) af[s] = *(LAS bf16x8*)(KST + (wave * 16 + fr) * 72 + s * 32 + fq * 8);
    bf16* ST = a.state + (size_t)(bh * 64 + n) * 32768;
#pragma unroll 4
    for (int vt = 0; vt < 16; ++vt) {
        bf16x8 b0, b1; gla_vfrag2(vs, (unsigned)lane, vt, b0, b1);
        f32x4 acc = {0.f, 0.f, 0.f, 0.f};
        acc = MFMA16(af[0], b0, acc); acc = MFMA16(af[1], b1, acc);
        u32x2 o; o.x = pk2(acc[0], acc[1]); o.y = pk2(acc[2], acc[3]);
        *(u32x2*)(ST + (size_t)(vt * 16 + fr) * 128 + wave * 16 + fq * 4) = o; }
    __syncthreads();
}
__device__ __forceinline__ void gla_scan(Frame& F, bf16* state, const float* dec) {
    int tid = threadIdx.x; asm volatile("" : "+v"(tid));
    for (int g = F.vcu * NTHR + tid; g < 16 * 8192; g += F.G * NTHR) {
        const int bh = g >> 13, e = (g & 8191) * 4, d = e & 127;
        bf16* p = state + (size_t)bh * 64 * 32768 + e; const float* dp = dec + (size_t)bh * 64 * 128 + d;
        f32x4 S = {0.f, 0.f, 0.f, 0.f};
#pragma unroll 8
        for (int n = 0; n < 64; ++n) { const u32x2 w = *(const u32x2*)(p + (size_t)n * 32768); const f32x4 dc = *(const f32x4*)(dp + n * 128);
            u32x2 o; o.x = pk2(S.x, S.y); o.y = pk2(S.z, S.w); *(u32x2*)(p + (size_t)n * 32768) = o;
            S.x = dc.x * S.x + bflo(w.x); S.y = dc.y * S.y + bfhi(w.x); S.z = dc.z * S.z + bflo(w.y); S.w = dc.w * S.w + bfhi(w.y); }
    }
}
__device__ __forceinline__ void gla_c_unit(Frame& F, const GlaArgs& a, int b, int n, int h) {
    int tid = threadIdx.x; asm volatile("" : "+v"(tid));
    const int lane = tid & 63, wave = F.wave, fr = lane & 15, fq = lane >> 4, d = tid & 127, cg = tid >> 7;
    LAS bf16* QD = (LAS bf16*)(F.lds + GL_QD); LAS bf16* KI = (LAS bf16*)(F.lds + GL_KI); LAS bf16* AM = (LAS bf16*)(F.lds + GL_AM); LAS float* RS = (LAS float*)(F.lds + GL_RS);
    const unsigned vs = (unsigned)(uintptr_t)(F.lds + GL_VS);
    const int tok0 = b * SEQ + n * 64, bh = b * 4 + h;
    const bf16* P = a.proj + (size_t)tok0 * LDP;
    u32x4 vw[4];
#pragma unroll
    for (int i = 0; i < 4; ++i) { const int id = tid + 512 * i; vw[i] = *(const u32x4*)(P + (size_t)(id >> 5) * LDP + C_GV + h * 256 + (id & 31) * 8); }
    const float* BC = a.bcum + ((size_t)(bh * 64 + n) * 64 + cg * 16) * 128 + d;
    float bc[16]; unsigned short qraw[16], kraw[16];
#pragma unroll
    for (int cc = 0; cc < 16; ++cc) { bc[cc] = BC[cc * 128]; qraw[cc] = P[(size_t)(cg * 16 + cc) * LDP + C_GQ + h * 128 + d]; kraw[cc] = P[(size_t)(cg * 16 + cc) * LDP + C_GK + h * 128 + d]; }
#pragma unroll
    for (int i = 0; i < 4; ++i) { const int id = tid + 512 * i, c = id >> 5, ch32 = id & 31;
        *(LAS u32x4*)(F.lds + GL_VS + ((c >> 5) * 2 + (ch32 >> 4)) * 8192 + gla_off_b((unsigned)(c & 31), (unsigned)(ch32 & 15))) = vw[i]; }
#pragma unroll
    for (int cc = 0; cc < 16; ++cc) { const int c = cg * 16 + cc; const float e = __expf(bc[cc]);
        QD[c * 136 + d] = (bf16)f2bf(bf2f(qraw[cc]) * 0.08838834764831845f * e);
        KI[c * 136 + d] = (bf16)f2bf(bf2f(kraw[cc]) * __expf(-bc[cc])); }
    __syncthreads();
    const int it = wave & 3, vh = wave >> 2, i = it * 16 + fr;
    const bf16* ST = a.state + (size_t)(bh * 64 + n) * 32768;
    bf16x8 sa[8][4]; u32x2 rw[8];
#pragma unroll
    for (int vt = 0; vt < 8; ++vt) { const int v0 = (vh * 8 + vt) * 16;
#pragma unroll
        for (int s = 0; s < 4; ++s) sa[vt][s] = *(const bf16x8*)(ST + (size_t)(v0 + fr) * 128 + s * 32 + fq * 8);
        rw[vt] = *(const u32x2*)(P + (size_t)i * LDP + C_GR + h * 256 + v0 + fq * 4); }
#pragma unroll
    for (int tt = 0; tt < 2; ++tt) { const int tile = wave * 2 + tt, ita = tile >> 2, jt = tile & 3;
        f32x4 acc = {0.f, 0.f, 0.f, 0.f};
        if (jt <= ita) {
#pragma unroll
            for (int s = 0; s < 4; ++s) { const bf16x8 ka = *(LAS bf16x8*)(KI + (jt * 16 + fr) * 136 + s * 32 + fq * 8), qb = *(LAS bf16x8*)(QD + (ita * 16 + fr) * 136 + s * 32 + fq * 8);
                acc = MFMA16(ka, qb, acc); } }
        const int ia = ita * 16 + fr, j0 = jt * 16 + fq * 4;
#pragma unroll
        for (int r = 0; r < 4; ++r) if (j0 + r > ia) acc[r] = 0.f;
        u32x2 o; o.x = pk2(acc[0], acc[1]); o.y = pk2(acc[2], acc[3]);
        *(LAS u32x2*)(AM + ia * 72 + j0) = o; }
    __syncthreads();
    bf16x8 bam[2], bqd[4];
#pragma unroll
    for (int s = 0; s < 2; ++s) bam[s] = *(LAS bf16x8*)(AM + i * 72 + s * 32 + fq * 8);
#pragma unroll
    for (int s = 0; s < 4; ++s) bqd[s] = *(LAS bf16x8*)(QD + i * 136 + s * 32 + fq * 8);
    f32x4 acc[8]; float ss = 0.f;
#pragma unroll
    for (int vt = 0; vt < 8; ++vt) {
        f32x4 c = {0.f, 0.f, 0.f, 0.f};
        { bf16x8 va0, va1; gla_vfrag2(vs, (unsigned)lane, vh * 8 + vt, va0, va1); c = MFMA16(va0, bam[0], c); c = MFMA16(va1, bam[1], c); }
#pragma unroll
        for (int s = 0; s < 4; ++s) c = MFMA16(sa[vt][s], bqd[s], c);
        acc[vt] = c; ss += (c[0] * c[0] + c[1] * c[1]) + (c[2] * c[2] + c[3] * c[3]); }
    ss += __shfl_xor(ss, 16); ss += __shfl_xor(ss, 32);
    if (fq == 0) RS[i * 2 + vh] = ss;
    __syncthreads();
    const float rstd = 1.0f / sqrtf((RS[i * 2] + RS[i * 2 + 1]) * (1.0f / 256.0f) + EPS);
#pragma unroll
    for (int vt = 0; vt < 8; ++vt) { const int v = (vh * 8 + vt) * 16 + fq * 4;
        const f32x4 gh = *(const f32x4*)(a.ghead + v);
        const float r0 = bflo(rw[vt].x), r1 = bfhi(rw[vt].x), r2 = bflo(rw[vt].y), r3 = bfhi(rw[vt].y);
        const float o0 = acc[vt][0] * rstd * gh.x * r0 / (1.0f + __expf(-r0)), o1 = acc[vt][1] * rstd * gh.y * r1 / (1.0f + __expf(-r1));
        const float o2 = acc[vt][2] * rstd * gh.z * r2 / (1.0f + __expf(-r2)), o3 = acc[vt][3] * rstd * gh.w * r3 / (1.0f + __expf(-r3));
        u32x2 o; o.x = pk2(o0, o1); o.y = pk2(o2, o3);
        *(u32x2*)(a.mixcat + (size_t)(tok0 + i) * MIXP + h * 256 + v) = o; }
    __syncthreads();
}

constexpr int IX_QI = 0, IX_PITCH = 1096, IX_WL = 70144, IX_H = 73728, IX_CL = 90112;
struct IdxArgs { const bf16* proj; const bf16* ikc; float* scr; unsigned long long* mask; };
__device__ __forceinline__ void idx_unit(Frame& F, const IdxArgs& a, int b, int q0) {
    int tid = threadIdx.x; asm volatile("" : "+v"(tid));
    const int lane = tid & 63, wave = F.wave, r32 = lane & 31, hi = lane >> 5;
    LAS bf16* QI = (LAS bf16*)(F.lds + IX_QI); LAS float* WL = (LAS float*)(F.lds + IX_WL);
    const size_t tokq = (size_t)b * SEQ + q0; const bf16* PQ = a.proj + tokq * LDP;
#pragma unroll
    for (int i = 0; i < 8; ++i) { const int id = tid + 512 * i, r = id >> 7, ch = id & 127;
        *(LAS u32x4*)(QI + r * IX_PITCH + ch * 8) = *(const u32x4*)(PQ + (size_t)r * LDP + C_IQ + ch * 8); }
    { const int r = tid >> 4, hh = tid & 15; WL[r * 16 + hh] = bf2f(PQ[(size_t)r * LDP + C_IW + hh]) * (0.03125f * 0.5f); }
    __syncthreads();
    { const int t = tid >> 4, d4 = (tid & 15) * 4; float q0 = 0.f, q1 = 0.f, q2 = 0.f, q3 = 0.f;
#pragma unroll
        for (int hh = 0; hh < 16; ++hh) { const float w = WL[t * 16 + hh]; const u32x2 qw = *(LAS u32x2*)(QI + t * IX_PITCH + hh * 64 + d4);
            q0 += w * bflo(qw.x); q1 += w * bfhi(qw.x); q2 += w * bflo(qw.y); q3 += w * bfhi(qw.y); }
        u32x2 o; o.x = pk2(q0, q1); o.y = pk2(q2, q3); *(LAS u32x2*)(QI + t * IX_PITCH + 1024 + d4) = o; }
    __syncthreads();
    float* scr = a.scr + (size_t)blockIdx.x * 32 * 4096;
    const int nk = q0 + 32, ng = (nk + 63) >> 6;
    const bf16* PK = a.ikc + (size_t)b * SEQ * 64;
#ifndef REP_SCORE
#define REP_SCORE 1
#endif
#ifndef REP_SEL
#define REP_SEL 1
#endif
    const int fr = lane & 15, fq = lane >> 4;
#define SC_QLOAD(QB, slot_) do { _Pragma("unroll") for (int qt = 0; qt < 2; ++qt) _Pragma("unroll") for (int s = 0; s < 2; ++s) \
        QB[qt][s] = *(LAS bf16x8*)(QI + (qt * 16 + fr) * IX_PITCH + (slot_) * 64 + s * 32 + fq * 8); } while (0)
#define SC_MMA(ACC, QB) do { _Pragma("unroll") for (int kt = 0; kt < 4; ++kt) _Pragma("unroll") for (int qt = 0; qt < 2; ++qt) ACC[kt][qt] = MFMA16(ka[kt][0], QB[qt][0], ((f32x4){0.f, 0.f, 0.f, 0.f})); \
        _Pragma("unroll") for (int kt = 0; kt < 4; ++kt) _Pragma("unroll") for (int qt = 0; qt < 2; ++qt) ACC[kt][qt] = MFMA16(ka[kt][1], QB[qt][1], ACC[kt][qt]); } while (0)
#define SC_ACCUM(ACC, hh_) do { const float w0 = WL[fr * 16 + (hh_)], w1 = WL[(16 + fr) * 16 + (hh_)]; \
        _Pragma("unroll") for (int kt = 0; kt < 4; ++kt) _Pragma("unroll") for (int qt = 0; qt < 2; ++qt) { const float w = qt ? w1 : w0; \
            const float s0 = __builtin_fmaf(w, __builtin_fabsf(ACC[kt][qt][0]), sc[kt][qt][0]); sc[kt][qt][0] = s0; \
            _Pragma("unroll") for (int r = 1; r < 4; ++r) { float s_ = sc[kt][qt][r]; asm("v_fma_f32 %0, %1, |%2|, %0" : "+v"(s_) : "v"(w), "v"(ACC[kt][qt][r]), "v"(s0)); sc[kt][qt][r] = s_; } } } while (0)
    for (int rs_ = 0; rs_ < REP_SCORE; ++rs_)
    {
    bf16x8 ka[4][2], kn[4][2];
    if (wave < ng) {
#pragma unroll
        for (int kt = 0; kt < 4; ++kt)
#pragma unroll
            for (int s = 0; s < 2; ++s) kn[kt][s] = *(const bf16x8*)(PK + (size_t)(wave * 64 + kt * 16 + fr) * 64 + s * 32 + fq * 8); }
    for (int g = wave; g < ng; g += 8) {
        const int kb = g * 64;
#pragma unroll
        for (int kt = 0; kt < 4; ++kt)
#pragma unroll
            for (int s = 0; s < 2; ++s) ka[kt][s] = kn[kt][s];
        if (g + 8 < ng) {
#pragma unroll
            for (int kt = 0; kt < 4; ++kt)
#pragma unroll
                for (int s = 0; s < 2; ++s) kn[kt][s] = *(const bf16x8*)(PK + (size_t)(kb + 512 + kt * 16 + fr) * 64 + s * 32 + fq * 8); }
        f32x4 sc[4][2], accA[4][2], accB[4][2]; bf16x8 qbA[2][2], qbB[2][2];
        SC_QLOAD(qbA, 16);
        SC_QLOAD(qbB, 0); SC_MMA(sc, qbA);
        __builtin_amdgcn_sched_barrier(0);
        SC_QLOAD(qbA, 1); SC_MMA(accA, qbB);
        __builtin_amdgcn_sched_barrier(0);
#pragma unroll 1
        for (int hh = 0; hh < 16; hh += 2) {
            SC_QLOAD(qbB, (hh + 2 < 16 ? hh + 2 : 15)); SC_MMA(accB, qbA); __builtin_amdgcn_sched_barrier(0);
            SC_ACCUM(accA, hh); __builtin_amdgcn_sched_barrier(0);
            SC_QLOAD(qbA, (hh + 3 < 16 ? hh + 3 : 15)); SC_MMA(accA, qbB); __builtin_amdgcn_sched_barrier(0);
            SC_ACCUM(accB, hh + 1); __builtin_amdgcn_sched_barrier(0);
        }
        if (rs_ == REP_SCORE - 1) {
#pragma unroll
        for (int kt = 0; kt < 4; ++kt)
#pragma unroll
            for (int qt = 0; qt < 2; ++qt) *(f32x4*)(scr + (size_t)(qt * 16 + fr) * 4096 + kb + kt * 16 + fq * 4) = sc[kt][qt]; }
    }
    }
#undef SC_QLOAD
#undef SC_MMA
#undef SC_ACCUM
    VM_WAIT(); __builtin_amdgcn_fence(__ATOMIC_RELEASE, "workgroup");
    __syncthreads();
    __builtin_amdgcn_fence(__ATOMIC_ACQUIRE, "workgroup");
    LAS unsigned* H = (LAS unsigned*)(F.lds + IX_H + wave * 2048); LAS float* CL = (LAS float*)(F.lds + IX_CL + wave * 1024);
    const float NINF = -__builtin_inff(), PINF = __builtin_inff();
#define SEL_FOR(body) _Pragma("unroll") for (int jj = 0; jj < 8; ++jj) { if (jj * 8 < nj) { _Pragma("unroll") for (int k8 = 0; k8 < 8; ++k8) { const int j = jj * 8 + k8; body } } }
#ifndef SEL_NPF
#define SEL_NPF 56
#endif
#define SEL_FORN(njv, body) _Pragma("unroll") for (int jj = 0; jj < 8; ++jj) { if (jj * 8 < (njv)) { _Pragma("unroll") for (int k8 = 0; k8 < 8; ++k8) { const int j = jj * 8 + k8; body } } }
    constexpr int NPF = SEL_NPF;
    float nx[NPF];
#pragma unroll
    for (int j = 0; j < NPF; ++j) nx[j] = NINF;
    { const int i0 = wave * 4, nj0 = (q0 + i0 + 1 + 63) >> 6; SEL_FORN(nj0, if (j < NPF) nx[j] = scr[(size_t)i0 * 4096 + j * 64 + lane]; ) }
#pragma unroll 1
    for (int rr_ = 0; rr_ < 4 * REP_SEL; ++rr_) { const int rr = rr_ & 3;
        const int i = wave * 4 + rr, q = q0 + i, nv = q + 1, nj = (nv + 63) >> 6;
        float sc[64];
#pragma unroll
        for (int j = 0; j < 64; ++j) sc[j] = NINF;
#pragma unroll
        for (int j = 0; j < NPF; ++j) { const int pos = j * 64 + lane; sc[j] = pos <= q ? nx[j] : NINF; }
        SEL_FOR( if (j >= NPF) { const int pos = j * 64 + lane; const float v = scr[(size_t)i * 4096 + pos]; sc[j] = pos <= q ? v : NINF; } )
        if (rr_ + 1 < 4 * REP_SEL) { const int i1 = wave * 4 + ((rr_ + 1) & 3), nj1 = (q0 + i1 + 1 + 63) >> 6; SEL_FORN(nj1, if (j < NPF) nx[j] = scr[(size_t)i1 * 4096 + j * 64 + lane]; ) }
        float tau = -3.0e38f;
        if (nv > 256) {
            float mn = -wave_max(-sc[0]), mx = wave_max(sc[0]);
            int r = 256; bool lvl0 = true;
#pragma unroll 1
            for (;;) {
                if (!(mx > mn)) { if (!lvl0) { tau = mn; break; } mx = mn + 1.0f; }
                const float scale = 512.0f / (mx - mn);
                *(LAS u32x4*)(H + 8 * lane) = (u32x4){0u, 0u, 0u, 0u}; *(LAS u32x4*)(H + 8 * lane + 4) = (u32x4){0u, 0u, 0u, 0u};
                if (lvl0) { SEL_FOR( const float v = sc[j]; int bb = (int)((v - mn) * scale); bb = bb < 0 ? 0 : (bb > 511 ? 511 : bb);
                                     if (v > NINF) __hip_atomic_fetch_add(H + bb, 1u, __ATOMIC_RELAXED, __HIP_MEMORY_SCOPE_WORKGROUP); ) }
                else { SEL_FOR( const float v = sc[j]; int bb = (int)((v - mn) * scale); bb = bb < 0 ? 0 : (bb > 511 ? 511 : bb);
                                if (v >= mn && v <= mx) __hip_atomic_fetch_add(H + bb, 1u, __ATOMIC_RELAXED, __HIP_MEMORY_SCOPE_WORKGROUP); ) }
                const u32x4 h0 = *(LAS u32x4*)(H + 8 * lane), h1 = *(LAS u32x4*)(H + 8 * lane + 4);
                const unsigned hb[8] = {h0.x, h0.y, h0.z, h0.w, h1.x, h1.y, h1.z, h1.w};
                const unsigned tot = (h0.x + h0.y) + (h0.z + h0.w) + (h1.x + h1.y) + (h1.z + h1.w);
                unsigned incl = tot;
#pragma unroll
                for (int o = 1; o < 64; o <<= 1) { const unsigned t = __shfl_down(incl, o); if (lane + o < 64) incl += t; }
                unsigned cum = incl - tot; int fb = 0; unsigned fabove = 0u, fcnt = 0u; bool found = false;
#pragma unroll
                for (int e = 7; e >= 0; --e) { const unsigned prev = cum; cum += hb[e]; if (prev < (unsigned)r && cum >= (unsigned)r) { fb = 8 * lane + e; fabove = prev; fcnt = hb[e]; found = true; } }
                const unsigned long long fbal = __ballot(found);
                const int src = fbal ? (int)__builtin_ctzll(fbal) : 0;
                const int bstar = __shfl(fb, src); const unsigned above = __shfl(fabove, src), cntb = __shfl(fcnt, src);
                r -= (int)above;
                const float lo_ = lvl0 ? -3.0e38f : mn, hi_ = lvl0 ? 3.0e38f : mx;
                if (cntb <= 256u) {
                    unsigned base = 0u;
                    SEL_FOR( const float v = sc[j]; int bb = (int)((v - mn) * scale); bb = bb < 0 ? 0 : (bb > 511 ? 511 : bb);
                             const bool m = (v >= lo_ && v <= hi_) && bb == bstar; const unsigned long long bal = __ballot(m);
                             if (bal) { const unsigned p = base + __builtin_amdgcn_mbcnt_hi((unsigned)(bal >> 32), __builtin_amdgcn_mbcnt_lo((unsigned)bal, 0u)); if (m) CL[p] = v; base += (unsigned)__popcll(bal); } )
                    float mine[4]; int cge[4];
#pragma unroll
                    for (int m4 = 0; m4 < 4; ++m4) { mine[m4] = (unsigned)(lane + 64 * m4) < cntb ? CL[lane + 64 * m4] : PINF; cge[m4] = 0; }
#pragma unroll 1
                    for (unsigned ci = 0; ci < cntb; ++ci) { const float c = CL[ci];
#pragma unroll
                        for (int m4 = 0; m4 < 4; ++m4) cge[m4] += (c >= mine[m4]) ? 1 : 0; }
                    float best = NINF;
#pragma unroll
                    for (int m4 = 0; m4 < 4; ++m4) if (cge[m4] >= r) best = fmaxf(best, mine[m4]);
                    tau = wave_max(best); break;
                }
                float nmn = PINF, nmx = NINF;
                SEL_FOR( const float v = sc[j]; int bb = (int)((v - mn) * scale); bb = bb < 0 ? 0 : (bb > 511 ? 511 : bb);
                         const bool m = (v >= lo_ && v <= hi_) && bb == bstar; nmn = fminf(nmn, m ? v : PINF); nmx = fmaxf(nmx, m ? v : NINF); )
                mn = -wave_max(-nmn); mx = wave_max(nmx); lvl0 = false;
            }
        }
        unsigned long long my = 0ull;
        SEL_FOR( const unsigned long long bal = __ballot(sc[j] >= tau); if (lane == j) my = bal; )
        a.mask[(tokq + i) * 64 + lane] = my;
    }
#undef SEL_FOR
#undef SEL_FORN
    __syncthreads();
}

struct DsaArgs { const bf16* proj; const unsigned long long* mask; const float* rel; bf16* mixcat; const unsigned char* k8; const unsigned char* v8t; const unsigned char* q8; };
__device__ __forceinline__ dsa::BlockRef<bf16, unsigned char> dsa_ref(const DsaArgs& a, int bh, int qb) {
    const int b = bh >> 3, h = bh & 7; const size_t row0 = (size_t)b * SEQ + (size_t)qb * 256;
    dsa::BlockRef<bf16, unsigned char> r;
    r.Q = a.proj + row0 * LDP + C_DQ + h * 128; r.K = a.proj + (size_t)b * SEQ * LDP + C_DK + h * 128; r.V = a.proj + (size_t)b * SEQ * LDP + C_DV + h * 128;
    r.O = (unsigned char*)a.mixcat + row0 * (2 * MIXP) + 2048 + h * 128; r.MK = a.mask + row0 * 64; r.P0 = qb * 256; r.K8 = a.k8 + (size_t)b * SEQ * 1024 + h * 128; r.V8 = a.v8t + (size_t)((b * 8 + h) * 128) * 4096; r.Q8 = a.q8 + row0 * 1024 + h * 128;
    return r;
}
__device__ __forceinline__ void dsa_phase(Frame& F, char* lds, const DsaArgs& a) {
    constexpr int NITEM = 32 * 8;
    int L = F.vcu; if (L >= NITEM) return;
    dsa::Seam<bf16> S;
    int curh = -1;
    for (; L < NITEM; L += F.G) {
        const int bh = L >> 3, y = L & 7, h = bh & 7;
        if (h != curh) { __syncthreads(); curh = h;
            int tl = threadIdx.x; asm volatile("" : "+v"(tl));
            if (tl < 128) { const int n = tl; int bk = n; if (n >= 16) { bk = 16 + (int)(logf((float)n * 0.0625f) / 2.0794415416798357f * 16.0f); bk = bk > 31 ? 31 : bk; }
                ((float*)(lds + dsa::BL_OFF))[n] = (a.rel[bk * 8 + h] - a.rel[31 * 8 + h]) * 11.313708498984761f; }
            __syncthreads(); }
        const dsa::BlockRef<bf16, unsigned char> r0 = dsa_ref(a, bh, y), r1 = dsa_ref(a, bh, 15 - y);
        dsa::causal_swa_prime<bf16, unsigned char>(r0, lds, S);
        dsa::causal_swa_block<bf16, unsigned char>(r0, r1, SEQ, lds, S);
        dsa::causal_swa_block<bf16, unsigned char>(r1, r1, SEQ, lds, S);
    }
}
struct XaSchedA { const bf16* kv; const bf16* wxq; int c, G;
    __device__ __forceinline__ bool next(int i, pg8::Unit& u) const { const int id = c + i * G; if (id >= 128) return false; const int bh = id >> 3, pn = id & 7, b = bh >> 2, h = bh & 3;
        u.pm = bh; u.pn = pn; u.a = (const char*)(kv + (size_t)(b * 256) * 4096 + h * 512); u.b = (const char*)(wxq + (size_t)(pn * 256) * 2048 + h * 512); u.c = (size_t)(bh * 256) * 2048 + pn * 256; return true; }
    __device__ __forceinline__ void a_ready(const pg8::Unit&) const {}
    __device__ __forceinline__ void done(const pg8::Unit&) const {} };
struct XaSchedB { const bf16* kv; const bf16* wxo; int c, G;
    __device__ __forceinline__ bool next(int i, pg8::Unit& u) const { const int id = c + i * G; if (id >= 128) return false; const int bh = id >> 3, pm = id & 7, b = bh >> 2, h = bh & 3;
        u.pm = pm; u.pn = bh; u.a = (const char*)(wxo + (size_t)(pm * 256) * 2048 + h * 512); u.b = (const char*)(kv + (size_t)(b * 256) * 4096 + 2048 + h * 512); u.c = (size_t)b * 2048 * 1024 + (size_t)(pm * 256) * 1024 + h * 256; return true; }
    __device__ __forceinline__ void a_ready(const pg8::Unit&) const {}
    __device__ __forceinline__ void done(const pg8::Unit&) const {} };

template <int PN0, int NPN, int NKV, int LD, int SKIP_AT, int SKIP_LEN, bool F8, int T0, int SKEW = -1>
struct InKvSchedT { unsigned char* ws; int G, c;
    __device__ __forceinline__ bool next(int i, pg8::Unit& u) const { constexpr int nin = 64 * NPN; int L = i * G + c;
        if (SKEW >= 0 && G == 256) { static_assert(SKEW < 0 || nin == 256 * SKEW + 256, "skewed dealing"); if (i >= SKEW) { if (c < 128 || i >= SKEW + 2) return false; L = SKEW * 256 + (i - SKEW) * 128 + (c - 128); } }
        if (L >= nin + NKV) return false;
        if (L < nin) { pg8::static_order(0, 0, L, MTOK / 256, NPN, u.pm, u.pn); u.pn += PN0; if (u.pn >= SKIP_AT) u.pn += SKIP_LEN;
            const bf16* h = (const bf16*)(ws + (F8 ? WS_BUFB : WS_XB)); const bf16* win = (const bf16*)(ws + WS_WIN + (F8 ? (size_t)T0 * 256 * DM : (size_t)0));
            u.a = (const char*)(h + (size_t)u.pm * 256 * LD); u.b = (const char*)(win + (size_t)u.pn * 256 * LD); u.o = (bf16*)(ws + WS_PROJ); u.ldc = LDP; u.c = (size_t)u.pm * 256 * LDP + (size_t)u.pn * 256;
            u.rs = (const float*)(ws + WS_SS); u.osc = F8 ? 1.0f / FP8_WIN_SCALE : 1.0f; }
        else { const int id = L - nin; u.pm = id & 3; u.pn = id >> 2;
            u.a = (const char*)((const bf16*)(ws + WS_MEMN) + (size_t)u.pm * 256 * DM); u.b = (const char*)((const bf16*)(ws + WS_WXKV) + (size_t)u.pn * 256 * DM); u.o = (bf16*)(ws + WS_KV); u.ldc = 4096;
            u.c = (size_t)u.pm * 256 * 4096 + (size_t)u.pn * 256; u.rs = nullptr; u.osc = 1.0f; }
        return true; }
    __device__ __forceinline__ void a_ready(const pg8::Unit&) const {}
    __device__ __forceinline__ void done(const pg8::Unit&) const {} };
#define INPROJ_CALLS(T0_) do { \
        if constexpr ((T0_) < 24) { InKvSchedT<(T0_), 24 - (T0_), 0, DM / 2, 1 << 30, 0, true, (T0_), ((24 - (T0_)) * 64 - 256) / 256> S{w_, F.G, cid}; \
            pg8::gemm_phase<pg8::EpiBf16U, decltype(S), true, true, true>(F.lds + RING_OFF, DM / 2, DM / 2, DM / 2, S, E); } \
        { InKvSchedT<0, (T0_) + (LDP - FP8_IN_ROWS) / 256, 64, DM, (T0_), 24 - (T0_), false, (T0_)> S{w_, F.G, cid}; \
            pg8::gemm_phase<pg8::EpiBf16U, decltype(S), true, true>(F.lds + RING_OFF, DM, DM, DM, S, E); } } while (0)

#define KAS __attribute__((address_space(4)))
#define WSBASE() const KAS Args* ka_ = (const KAS Args*)__builtin_amdgcn_kernarg_segment_ptr(); asm volatile("" : "+s"(ka_)); unsigned char* w_ = ka_->ws; const float* g = ka_->in[2] + (size_t)l * 7 * DM; (void)g; \
    int cid = (int)blockIdx.x; asm volatile("" : "+s"(cid), "+s"(F.vcu), "+s"(F.wave), "+s"(F.G))
#define WIN ((bf16*)(w_ + WS_WIN))
#define WOUT ((bf16*)(w_ + WS_WOUT))
#define WXQ ((bf16*)(w_ + WS_WXQ))
#define WXKV ((bf16*)(w_ + WS_WXKV))
#define WXO ((bf16*)(w_ + WS_WXO))
#define WFI ((bf16*)(w_ + WS_WFI))
#define WFO ((bf16*)(w_ + WS_WFO))
#define MEMN ((bf16*)(w_ + WS_MEMN))
#define KV ((bf16*)(w_ + WS_KV))
#define AT ((bf16*)(w_ + WS_AT))
#define BT2 ((bf16*)(w_ + WS_BT2))
#define PROJ ((bf16*)(w_ + WS_PROJ))
#define ACT ((bf16*)(w_ + WS_ACT))
#define LOGIT ((float*)(w_ + WS_LOGIT))
#define PROB ((bf16*)(w_ + WS_PROB))
#define BUFA ((bf16*)(w_ + WS_BUFA))
#define BUFB ((bf16*)(w_ + WS_BUFB))
#define SCR ((float*)(w_ + WS_SCR))
#define MASK ((unsigned long long*)((unsigned char*)ka_->out + DO_MASK))
#define PART ((float*)(w_ + WS_PART))
#define DEC ((float*)(w_ + WS_DEC))
#define BCUM ((float*)((unsigned char*)ka_->out + DO_BCUM))
#define XB ((bf16*)(w_ + WS_XB))
#define SS ((float*)(w_ + WS_SS))
#define FUSED_NORM(inst, gpost, outf, xb8) do { int pm_, pn_; pg8::static_order(0, 256, cid, MTOK / 256, DM / 256, pm_, pn_); \
    panel_sync((unsigned*)(F.ctl + CW_PANEL + ((inst) * 64 + pm_) * 64), (unsigned*)(F.ctl + CW_BAR) + XB_TMO); \
    norm_rows(pm_ * 256 + pn_ * 64, pm_ * 256 + pn_ * 64 + 64, F.wave, NWAVES, XB, BUFA, PART, (gpost), SS, (outf), (xb8)); } while (0)
#define FUSED (FUSE_NORM && F.G == 256)
constexpr int NPH = 14, NPHASE = NPH * DEPTH;
struct Args { const float* in[14]; float* out; unsigned char* ws; int ph_lo, ph_hi; };
#ifndef REPEAT_MASK
#define REPEAT_MASK 0
#endif
#ifndef REP_GLA
#define REP_GLA 1
#endif
__global__ void __launch_bounds__(NTHR, 2) hymba_fwd(Args args) {
    extern __shared__ __attribute__((aligned(16))) unsigned char lds[];
    Frame F;
    F.lds = (LAS unsigned char*)lds;
    F.MISC = (volatile LAS unsigned*)(F.lds + MISC_OFF);
    F.tid = threadIdx.x; F.lane = F.tid & 63; F.wave = __builtin_amdgcn_readfirstlane(F.tid >> 6);
    F.G = gridDim.x; { const int bx = blockIdx.x; F.vcu = (F.G % 8 == 0) ? (bx % 8) * (F.G / 8) + bx / 8 : bx; }
    F.ws = nullptr;
    F.ctl = (gu32*)(args.ws + WS_CTL);
    for (int u = F.tid; u < (LDS_BYTES - LDSCTL_OFF) / 4; u += NTHR) ((LAS unsigned*)(F.lds + LDSCTL_OFF))[u] = 0u;
    __syncthreads();
    XcdBarrier bar; bar.bar = (unsigned*)(F.ctl + CW_BAR); bar.x = 0; bar.st = nullptr;
#if !MK_MULTI
    bar = xcd_barrier_post((unsigned*)(F.ctl + CW_BAR), F.MISC + 8);
#endif
    const int lo = args.ph_lo, hi = args.ph_hi;
#define IN(k) (lo <= pb + (k) && pb + (k) < hi)
#define PHASE(k) for (int rep_ = 0; rep_ < (IN(k) ? 1 + ((REPEAT_MASK >> (k)) & 1) : 0); ++rep_)
#ifndef REP_BAR
#define REP_BAR 1
#endif
#ifndef REP_NORM
#define REP_NORM 0
#endif
#define SEAM(k) do { if (!MK_MULTI && IN(k) && lo <= pb + (k) + 1 && pb + (k) + 1 < hi) { for (int rb_ = 0; rb_ < REP_BAR; ++rb_) xcd_barrier(bar); } } while (0)
#define MKGA() GlaArgs ga; ga.proj = PROJ; ga.w2 = ka_->in[4] + (size_t)l * 16 * 512; ga.bg = ka_->in[5] + (size_t)l * 512; ga.ghead = ka_->in[6] + (size_t)l * 256; ga.state = BUFA; ga.dec = DEC; ga.bcum = BCUM; ga.mixcat = BUFB

    for (int l = 0; l < DEPTH; ++l) {
        const int pb = l * NPH;
        PHASE(0) { WSBASE(); P0Args pa; pa.ws = w_; pa.x = ka_->in[0]; pa.mem = ka_->in[1]; pa.gains = ka_->in[2]; pa.w_in = ka_->in[3] + (size_t)l * DM * D_IN; pa.w_out = ka_->in[8] + (size_t)l * DM * DM; pa.w_xq = ka_->in[9] + (size_t)l * DM * DM;
            pa.w_xkv = ka_->in[10] + (size_t)l * DM * 2 * DM; pa.w_xo = ka_->in[11] + (size_t)l * DM * DM; pa.w_fi = ka_->in[12] + (size_t)l * DM * 2 * DFF; pa.w_fo = ka_->in[13] + (size_t)l * DFF * DM; pa.layer = l; pa.fp8 = (FP8_LAYERS >> l) & 1; pa.fp8in = (FP8_INPROJ >> l) & 1; pa.fp8fo = (FP8_FFN_OUT >> l) & 1;
            p0_prologue(F, pa); }
        SEAM(0);
        PHASE(1) { WSBASE(); pg8::EpiBf16U E{(bf16*)(w_ + WS_IKC), (unsigned char*)ka_->out + DO_V8T, (unsigned char*)ka_->out + DO_Q8, (unsigned char*)ka_->out + DO_K8};
#if FP8_INPROJ == 3
            if (l == 0) INPROJ_CALLS(FP8_IN_T0_L0); else INPROJ_CALLS(FP8_IN_T0_L1);
#elif FP8_INPROJ == 2
            if (l == 0) INPROJ_CALLS(24); else INPROJ_CALLS(FP8_IN_T0_L1);
#elif FP8_INPROJ == 1
            if (l == 0) INPROJ_CALLS(FP8_IN_T0_L0); else INPROJ_CALLS(24);
#else
            INPROJ_CALLS(24);
#endif
        }
        SEAM(1);
        PHASE(2) { WSBASE(); MKGA();
#ifndef NO_GLA
            for (int rg_ = 0; rg_ < REP_GLA; ++rg_)
            for (int u = F.vcu; u < 1024; u += F.G) gla_a_unit(F, ga, u >> 8, (u >> 2) & 63, u & 3);
#endif
#ifndef NO_IDX
            IdxArgs ia; ia.proj = PROJ; ia.ikc = (const bf16*)(w_ + WS_IKC); ia.scr = SCR; ia.mask = MASK;
            for (int p = F.vcu; p < 256; p += F.G) { const int b = p >> 6, pp = p & 63; idx_unit(F, ia, b, pp * 32); idx_unit(F, ia, b, (127 - pp) * 32); }
#endif
        }
        SEAM(2);
        PHASE(3) { WSBASE();
            if (cid < F.G / 2) { XaSchedA S{KV, WXQ, cid, F.G / 2}; pg8::EpiBf16 E{AT, DM}; pg8::gemm_phase<pg8::EpiBf16, XaSchedA, true, true>(F.lds + RING_OFF, 512, 4096, DM, S, E); }
            else { XaSchedB S{KV, WXO, cid - F.G / 2, F.G - F.G / 2}; pg8::EpiBf16 E{BT2, 1024}; pg8::gemm_phase<pg8::EpiBf16, XaSchedB, true, true>(F.lds + RING_OFF, 512, DM, 4096, S, E); }
            gla_scan(F, BUFA, DEC); }
        SEAM(3);
        PHASE(4) { WSBASE(); MKGA();
#ifndef NO_GLA
            for (int rg_ = 0; rg_ < REP_GLA; ++rg_)
            for (int u = F.vcu; u < 1024; u += F.G) gla_c_unit(F, ga, u >> 8, (u >> 2) & 63, u & 3);
#endif
#ifndef NO_DSA
            DsaArgs da; da.proj = PROJ; da.mask = MASK; da.rel = ka_->in[7]; da.mixcat = BUFB; da.k8 = (const unsigned char*)ka_->out + DO_K8; da.v8t = (const unsigned char*)ka_->out + DO_V8T; da.q8 = (const unsigned char*)ka_->out + DO_Q8;
#ifndef REP_DSA
#define REP_DSA 1
#endif
            for (int rd_ = 0; rd_ < REP_DSA; ++rd_) dsa_phase(F, (char*)lds + RING_OFF, da);
#endif
        }
        SEAM(4);
        PHASE(5) { WSBASE(); pg8::PlainSched S{BUFB, WOUT, MIXP, MIXP, MTOK / 256, DM / 256, F.G, cid, 0, 0, 0, 0}; pg8::EpiBf16Part E{BUFA, PART, 1.0f};
            pg8::gemm_phase<pg8::EpiBf16Part, pg8::PlainSched, true, true, false, 16>(F.lds + RING_OFF, MIXP, MIXP, MIXP, S, E);
            if (FUSED) FUSED_NORM(l * 3 + 0, g + 1 * DM, (float*)nullptr, (unsigned char*)nullptr); }
        if (!FUSED) SEAM(5);
        PHASE(6) { WSBASE(); if (!FUSED) norm_phase(F, XB, BUFA, PART, g + 1 * DM, SS, nullptr); }
        SEAM(6);
        PHASE(7) { WSBASE(); pg8::PlainSched S{XB, AT, DM, DM, MTOK / 256, 1024 / 256, F.G, cid, 16, (size_t)1024 * DM, 0, 0};
#if FUSE_SOFTMAX
            pg8::EpiSoftmaxP E{PROB, SS, (LAS float*)(F.lds + LDSCTL_OFF + 1024), (LAS float*)(F.lds + LDSCTL_OFF + 1024 + 4096)};
            pg8::gemm_phase<pg8::EpiSoftmaxP, pg8::PlainSched, true, true>(F.lds + RING_OFF, DM, DM, DM, S, E); }
#else
            pg8::EpiF32 E{LOGIT, 1024};
            pg8::gemm_phase<pg8::EpiF32, pg8::PlainSched, true, true>(F.lds + RING_OFF, DM, DM, DM, S, E); }
        SEAM(7);
#endif
        PHASE(8) { WSBASE(); if (!FUSE_SOFTMAX) xsoftmax_phase(F, LOGIT, PROB, SS); }
        SEAM(8);
        PHASE(9) { WSBASE(); pg8::PlainSched S{PROB, BT2, 1024, 1024, MTOK / 256, DM / 256, F.G, cid, 16, (size_t)DM * 1024, 0, 0}; pg8::EpiBf16Part E{BUFA, PART, 1.0f};
            pg8::gemm_phase<pg8::EpiBf16Part, pg8::PlainSched, true, true>(F.lds + RING_OFF, 1024, 1024, 1024, S, E);
            if (FUSED) FUSED_NORM(l * 3 + 1, g + 3 * DM, (float*)nullptr, ((FP8_LAYERS >> l) & 1) ? (unsigned char*)BUFB : (unsigned char*)nullptr); }
        if (!FUSED) SEAM(9);
        PHASE(10) { WSBASE(); if (!FUSED) norm_phase(F, XB, BUFA, PART, g + 3 * DM, SS, nullptr, ((FP8_LAYERS >> l) & 1) ? (unsigned char*)BUFB : nullptr); }
        SEAM(10);
        PHASE(11) { WSBASE();
            if ((FP8_LAYERS >> l) & 1) { pg8::PlainSched S{(const bf16*)BUFB, WFI, DM / 2, DM / 2, MTOK / 256, 2 * DFF / 256, F.G, cid, 0, 0, 0, 0}; pg8::EpiSwiglu8 E{(unsigned char*)ACT, DFF, SS, 1.0f / FP8_WFI_SCALE, FP8_ACT_SCALE};
                pg8::gemm_phase<pg8::EpiSwiglu8, pg8::PlainSched, true, true, true>(F.lds + RING_OFF, DM / 2, DM / 2, DM / 2, S, E); }
            else if ((FP8_FFN_OUT >> l) & 1) { pg8::PlainSched S{XB, WFI, DM, DM, MTOK / 256, 2 * DFF / 256, F.G, cid, 0, 0, 0, 0}; pg8::EpiSwiglu8 E{(unsigned char*)ACT, DFF, SS, 1.0f, FP8_ACT_SCALE};
                pg8::gemm_phase<pg8::EpiSwiglu8, pg8::PlainSched, true, true>(F.lds + RING_OFF, DM, DM, DM, S, E); }
            else { pg8::PlainSched S{XB, WFI, DM, DM, MTOK / 256, 2 * DFF / 256, F.G, cid, 0, 0, 0, 0}; pg8::EpiSwiglu E{ACT, DFF, SS};
                pg8::gemm_phase<pg8::EpiSwiglu, pg8::PlainSched, true, true>(F.lds + RING_OFF, DM, DM, DM, S, E); } }
        SEAM(11);
        PHASE(12) { WSBASE();
            if ((FP8_FFN_OUT >> l) & 1) { pg8::PlainSched S{ACT, WFO, DFF / 2, DFF / 2, MTOK / 256, DM / 256, F.G, cid, 0, 0, 0, 0}; pg8::EpiBf16Part E{BUFA, PART, 1.0f / (FP8_WFO_SCALE * FP8_ACT_SCALE)};
                pg8::gemm_phase<pg8::EpiBf16Part, pg8::PlainSched, true, true, true>(F.lds + RING_OFF, DFF / 2, DFF / 2, DFF / 2, S, E); }
            else { pg8::PlainSched S{ACT, WFO, DFF, DFF, MTOK / 256, DM / 256, F.G, cid, 0, 0, 0, 0}; pg8::EpiBf16Part E{BUFA, PART, 1.0f};
                pg8::gemm_phase<pg8::EpiBf16Part, pg8::PlainSched, true, true>(F.lds + RING_OFF, DFF, DFF, DFF, S, E); }
            if (FUSED) FUSED_NORM(l * 3 + 2, g + 5 * DM, l + 1 < DEPTH ? (float*)nullptr : ka_->out, (l + 1 < DEPTH && ((FP8_INPROJ >> (l + 1)) & 1)) ? (unsigned char*)BUFB : (unsigned char*)nullptr); }
        if (!FUSED) SEAM(12);
        PHASE(13) { WSBASE(); if (!FUSED) norm_phase(F, XB, BUFA, PART, g + 5 * DM, SS, l + 1 < DEPTH ? nullptr : ka_->out, (l + 1 < DEPTH && ((FP8_INPROJ >> (l + 1)) & 1)) ? (unsigned char*)BUFB : nullptr); }
        SEAM(13);
    }
#undef IN
#undef SEAM
#undef PHASE
}

extern "C" void kernel_launch(void* const* d_in, const int* in_sizes, int n_in, void* d_out, int out_size, void* d_ws, size_t ws_size, hipStream_t stream) {
    static int grid = 0;
    if (grid == 0) {
        if (n_in != 14 || out_size != MTOK * DM || ws_size < WS_END) { fprintf(stderr, "kernel_launch: unexpected shapes (n_in %d, out %d, ws %zu < %zu)\n", n_in, out_size, ws_size, (size_t)WS_END); grid = -1; return; }
        int dev = 0, cus = 0, per_cu = 0;
        if (hipGetDevice(&dev) != hipSuccess || hipDeviceGetAttribute(&cus, hipDeviceAttributeMultiprocessorCount, dev) != hipSuccess) { grid = -1; return; }
        if (hipFuncSetAttribute((const void*)hymba_fwd, hipFuncAttributeMaxDynamicSharedMemorySize, LDS_BYTES) != hipSuccess) { fprintf(stderr, "kernel_launch: hipFuncSetAttribute failed\n"); grid = -1; return; }
        if (hipOccupancyMaxActiveBlocksPerMultiprocessor(&per_cu, (const void*)hymba_fwd, NTHR, LDS_BYTES) != hipSuccess || per_cu < 1) { fprintf(stderr, "kernel_launch: occupancy query says %d workgroups per CU\n", per_cu); }
        (void)hipGetLastError();
        grid = cus;
    }
    if (grid < 0) return;
    if (hipMemsetAsync((char*)d_ws + WS_CTL, 0, CTL_ZERO_BYTES, stream) != hipSuccess) return;
    Args a{};
    for (int i = 0; i < 14; ++i) a.in[i] = (const float*)d_in[i];
    a.out = (float*)d_out; a.ws = (unsigned char*)d_ws;
#if MK_MULTI
    for (int p = 0; p < NPHASE; ++p) { a.ph_lo = p; a.ph_hi = p + 1; hipLaunchKernelGGL(hymba_fwd, dim3(grid), dim3(NTHR), LDS_BYTES, stream, a); }
#else
    a.ph_lo = 0; a.ph_hi = NPHASE; hipLaunchKernelGGL(hymba_fwd, dim3(grid), dim3(NTHR), LDS_BYTES, stream, a);
#endif
    (void)in_sizes;
}
```

```cpp
#include <hip/hip_runtime.h>
#include <cstdio>
#include <cstdint>

#ifndef MK_MULTI
#define MK_MULTI 0
#endif

#define LAS __attribute__((address_space(3)))
#define GAS __attribute__((address_space(1)))
typedef unsigned short bf16;
typedef short bf16x8 __attribute__((ext_vector_type(8)));
typedef short s16x4 __attribute__((ext_vector_type(4)));
typedef float f32x2 __attribute__((ext_vector_type(2)));
typedef float f32x4 __attribute__((ext_vector_type(4)));
typedef float f32x16 __attribute__((ext_vector_type(16)));
typedef unsigned u32x2 __attribute__((ext_vector_type(2)));
typedef unsigned u32x4 __attribute__((ext_vector_type(4)));
typedef GAS unsigned gu32;

namespace pg8 {
#define PG8_LAS __attribute__((address_space(3)))
typedef unsigned short bf16_t;
constexpr int BM = 256, BK = 64, HALF = 128, HTB = HALF * BK * 2  , STAGE_BYTES = 8 * HTB, NXCD = 8, WGM = 8;

__host__ __device__ __forceinline__ int lds_byte(int r, int c) { const int st = (r >> 4) * 2 + (c >> 5), rr = r & 15, cc = c & 31, ob = rr * 64 + cc * 2; return st * 1024 + (ob ^ (((ob >> 9) & 1) << 5)); }
__host__ __device__ __forceinline__ void stage_rc(int b, int& R, int& C) { const int st = b / 1024, sb = b % 1024, swz = sb ^ (((sb >> 9) & 1) << 5); R = (st >> 1) * 16 + swz / 64; C = (st & 1) * 32 + (swz % 64) / 2; }
__host__ __device__ __forceinline__ int perm32(int rho) { const int n = rho >> 4, i = rho & 15; return 8 * (i >> 2) + 4 * n + (i & 3); }

struct Unit { int pm, pn; const char* a; const char* b; size_t c; bf16_t* o; int ldc; const float* rs; float osc; };

__device__ __forceinline__ bool static_order(int i, int G, int c, int nM, int nN, int& pm, int& pn) {
    const int nwg = nM * nN; const long L = (long)i * G + c; if (L >= nwg) return false;
    int wgid = (int)L; { const int q = nwg / NXCD, r = nwg % NXCD, xcd = wgid % NXCD, off = wgid / NXCD; wgid = (xcd < r ? xcd * (q + 1) : r * (q + 1) + (xcd - r) * q) + off; }
    const int nig = WGM * nN, gid = wgid / nig, fm = gid * WGM, gsz = (nM - fm) < WGM ? (nM - fm) : WGM;
    pm = fm + ((wgid % nig) % gsz); pn = (wgid % nig) / gsz; return true;
}
struct PlainSched {
    const bf16_t* A; const bf16_t* Bt; int lda, ldb, nM, nN, G, c, bper; size_t bstride, crs, ccs;
    __device__ __forceinline__ bool next(int i, Unit& u) const {
        if (!static_order(i, G, c, nM, nN, u.pm, u.pn)) return false;
        u.a = (const char*)(A + (size_t)u.pm * BM * lda);
        u.b = (const char*)(Bt + (bper ? (size_t)(u.pm / bper) * bstride : (size_t)0) + (size_t)u.pn * BM * ldb);
        u.c = (size_t)u.pm * crs + (size_t)u.pn * ccs;
        return true;
    }
    __device__ __forceinline__ void a_ready(const Unit&) const {}
    __device__ __forceinline__ void done(const Unit&) const {}
};

typedef int i32x8 __attribute__((ext_vector_type(8)));
typedef int i32x4 __attribute__((ext_vector_type(4)));
__device__ __forceinline__ i32x8 cat8(bf16x8 a, bf16x8 b) { const i32x4 x = __builtin_bit_cast(i32x4, a), y = __builtin_bit_cast(i32x4, b); return __builtin_shufflevector(x, y, 0, 1, 2, 3, 4, 5, 6, 7); }
__device__ __forceinline__ unsigned cvt_pk_bf16(float lo, float hi) { unsigned r; asm volatile("v_cvt_pk_bf16_f32 %0, %1, %2" : "=v"(r) : "v"(lo), "v"(hi)); return r; }

struct EpiBf16 {
    static constexpr bool PERM = true, AFTER_DRAIN = false;
    bf16_t* O; int ldc;
    __device__ __forceinline__ void operator()(const f32x4 (&acc)[2][2][4][2], const Unit& u, int wr, int wc, int fr, int fq) const {
        bf16_t* base = O + u.c + (size_t)(wr * 64 + fr) * ldc + wc * 32 + 8 * fq;
#pragma unroll
        for (int ai = 0; ai < 2; ++ai)
#pragma unroll
            for (int m = 0; m < 4; ++m) { bf16_t* rowp = base + (size_t)(ai * HALF + m * 16) * ldc;
#pragma unroll
                for (int bj = 0; bj < 2; ++bj) { const f32x4 v0 = acc[ai][bj][m][0], v1 = acc[ai][bj][m][1];
                    u32x4 w; w.x = cvt_pk_bf16(v0[0], v0[1]); w.y = cvt_pk_bf16(v0[2], v0[3]); w.z = cvt_pk_bf16(v1[0], v1[1]); w.w = cvt_pk_bf16(v1[2], v1[3]);
                    *(u32x4*)(rowp + bj * HALF) = w; } }
    }
};
__device__ __forceinline__ unsigned pk4_e4m3(float a, float b, float c, float d) { unsigned w = 0u; w = __builtin_amdgcn_cvt_pk_fp8_f32(a, b, w, false); w = __builtin_amdgcn_cvt_pk_fp8_f32(c, d, w, true); return w; }
struct EpiBf16U {
    static constexpr bool PERM = true, AFTER_DRAIN = false;
    bf16_t* ikc;
    unsigned char* v8t;
    unsigned char* k8;
    __device__ __forceinline__ void operator()(const f32x4 (&acc)[2][2][4][2], const Unit& u, int wr, int wc, int fr, int fq) const {
        const int ldc = u.ldc; const float* rs = u.rs;
        bf16_t* base = u.o + u.c + (size_t)(wr * 64 + fr) * ldc + wc * 32 + 8 * fq;
#pragma unroll
        for (int ai = 0; ai < 2; ++ai)
#pragma unroll
            for (int m = 0; m < 4; ++m) { bf16_t* rowp = base + (size_t)(ai * HALF + m * 16) * ldc;
                const float sc = rs ? u.osc / sqrtf(rs[u.pm * BM + wr * 64 + fr + ai * HALF + m * 16] * (1.0f / 2048.0f) + 1e-6f) : u.osc;
#pragma unroll
                for (int bj = 0; bj < 2; ++bj) { const f32x4 v0 = acc[ai][bj][m][0] * sc, v1 = acc[ai][bj][m][1] * sc;
                    u32x4 w; w.x = cvt_pk_bf16(v0[0], v0[1]); w.y = cvt_pk_bf16(v0[2], v0[3]); w.z = cvt_pk_bf16(v1[0], v1[1]); w.w = cvt_pk_bf16(v1[2], v1[3]);
                    if (!(u.pn >= 16 && u.pn < 24 && u.ldc != 4096)) *(u32x4*)(rowp + bj * HALF) = w;
                    if (u.pn >= 20 && u.pn < 24 && u.ldc != 4096) { const unsigned a0 = pk4_e4m3(v0[0], v0[1], v0[2], v0[3]), a1 = pk4_e4m3(v1[0], v1[1], v1[2], v1[3]);
                        const int row = u.pm * BM + wr * 64 + fr + ai * HALF + m * 16, col = (u.pn - 20) * 256 + bj * HALF + wc * 32 + 8 * fq;
                        unsigned char* vp = v8t + ((size_t)(row >> 12) * 1024 + col) * 4096 + (row & 4095);
                        vp[0] = (unsigned char)a0; vp[4096] = (unsigned char)(a0 >> 8); vp[2 * 4096] = (unsigned char)(a0 >> 16); vp[3 * 4096] = (unsigned char)(a0 >> 24);
                        vp[4 * 4096] = (unsigned char)a1; vp[5 * 4096] = (unsigned char)(a1 >> 8); vp[6 * 4096] = (unsigned char)(a1 >> 16); vp[7 * 4096] = (unsigned char)(a1 >> 24); }
                    if (u.pn >= 16 && u.pn < 20 && u.ldc != 4096) { u32x2 w8; w8.x = pk4_e4m3(v0[0], v0[1], v0[2], v0[3]); w8.y = pk4_e4m3(v1[0], v1[1], v1[2], v1[3]);
                        *(u32x2*)(k8 + (size_t)(u.pm * BM + wr * 64 + fr + ai * HALF + m * 16) * 1024 + (u.pn - 16) * 256 + bj * HALF + wc * 32 + 8 * fq) = w8; }
                    if (bj == 0 && u.pn == 28 && u.ldc != 4096) { const int tc = wc * 32 + 8 * fq; if (tc >= 16 && tc < 80) *(u32x4*)(ikc + (size_t)(u.pm * BM + wr * 64 + fr + ai * HALF + m * 16) * 64 + (tc - 16)) = w; } } }
    }
};
struct EpiBf16Part {
    static constexpr bool PERM = true, AFTER_DRAIN = false;
    bf16_t* O; float* part; float osc;
    __device__ __forceinline__ void operator()(const f32x4 (&acc)[2][2][4][2], const Unit& u, int wr, int wc, int fr, int fq) const {
        const int row0 = u.pm * BM + wr * 64 + fr, col0 = u.pn * BM + wc * 32 + 8 * fq;
#pragma unroll
        for (int ai = 0; ai < 2; ++ai)
#pragma unroll
            for (int m = 0; m < 4; ++m) { const int row = row0 + ai * HALF + m * 16; bf16_t* rowp = O + (size_t)row * 2048 + col0; float ss = 0.f;
#pragma unroll
                for (int bj = 0; bj < 2; ++bj) { const f32x4 v0 = acc[ai][bj][m][0] * osc, v1 = acc[ai][bj][m][1] * osc;
                    ss += (v0[0] * v0[0] + v0[1] * v0[1]) + (v0[2] * v0[2] + v0[3] * v0[3]) + (v1[0] * v1[0] + v1[1] * v1[1]) + (v1[2] * v1[2] + v1[3] * v1[3]);
                    u32x4 w; w.x = cvt_pk_bf16(v0[0], v0[1]); w.y = cvt_pk_bf16(v0[2], v0[3]); w.z = cvt_pk_bf16(v1[0], v1[1]); w.w = cvt_pk_bf16(v1[2], v1[3]);
                    *(u32x4*)(rowp + bj * HALF) = w; }
                ss += __shfl_xor(ss, 16); ss += __shfl_xor(ss, 32);
                if (fq == 0) part[(size_t)row * 32 + u.pn * 4 + wc] = ss; }
    }
};
struct EpiF32 {
    static constexpr bool PERM = false, AFTER_DRAIN = false;
    float* C; int ldc;
    __device__ __forceinline__ void operator()(const f32x4 (&acc)[2][2][4][2], const Unit& u, int wr, int wc, int fr, int fq) const {
        const int row0 = u.pm * BM + wr * 64 + fr, col0 = u.pn * BM + wc * 32 + 4 * fq;
#pragma unroll
        for (int ai = 0; ai < 2; ++ai)
#pragma unroll
            for (int m = 0; m < 4; ++m) { float* rowp = C + (size_t)(row0 + ai * HALF + m * 16) * ldc + col0;
#pragma unroll
                for (int bj = 0; bj < 2; ++bj)
#pragma unroll
                    for (int n = 0; n < 2; ++n) *(f32x4*)(rowp + bj * HALF + n * 16) = acc[ai][bj][m][n]; }
    }
};
struct EpiSwiglu8 {
    static constexpr bool PERM = true, AFTER_DRAIN = false;
    unsigned char* O; int ldc; const float* rs; float isc, osc;
    __device__ __forceinline__ void operator()(const f32x4 (&acc)[2][2][4][2], const Unit& u, int wr, int wc, int fr, int fq) const {
        const int row0 = u.pm * BM + wr * 64 + fr, col0 = u.pn * HALF + wc * 32 + 8 * fq;
#pragma unroll
        for (int ai = 0; ai < 2; ++ai)
#pragma unroll
            for (int m = 0; m < 4; ++m) { unsigned char* rowp = O + (size_t)(row0 + ai * HALF + m * 16) * ldc + col0; float o[8];
                const float sc = isc / sqrtf(rs[row0 + ai * HALF + m * 16] * (1.0f / 2048.0f) + 1e-6f);
                const float cr = -1.4426950408889634f * sc, kr = sc * sc * osc;
#pragma unroll
                for (int n = 0; n < 2; ++n)
#pragma unroll
                    for (int j = 0; j < 4; ++j) { const float g = acc[ai][0][m][n][j], up = acc[ai][1][m][n][j];
                        o[n * 4 + j] = (g * up) * kr * __builtin_amdgcn_rcpf(1.0f + __builtin_amdgcn_exp2f(g * cr)); }
                u32x2 w; w.x = pk4_e4m3(o[0], o[1], o[2], o[3]); w.y = pk4_e4m3(o[4], o[5], o[6], o[7]);
                *(u32x2*)rowp = w; }
    }
};
struct EpiSoftmaxP {
    static constexpr bool PERM = true, AFTER_DRAIN = false;
    bf16_t* P; const float* rs; PG8_LAS float* tabM; PG8_LAS float* tabS;
    __device__ __forceinline__ void operator()(const f32x4 (&acc)[2][2][4][2], const Unit& u, int wr, int wc, int fr, int fq) const {
        const int row0 = u.pm * BM + wr * 64 + fr, col0 = u.pn * BM + wc * 32 + 8 * fq;
        float c2[2][4], mx[2][4];
#pragma unroll
        for (int ai = 0; ai < 2; ++ai)
#pragma unroll
            for (int m = 0; m < 4; ++m) { const int lr = ai * HALF + wr * 64 + m * 16 + fr;
                c2[ai][m] = (1.4426950408889634f * 0.04419417382415922f) / sqrtf(rs[u.pm * BM + lr] * (1.0f / 2048.0f) + 1e-6f);
                float v = acc[ai][0][m][0][0];
#pragma unroll
                for (int bj = 0; bj < 2; ++bj)
#pragma unroll
                    for (int n = 0; n < 2; ++n)
#pragma unroll
                        for (int j = 0; j < 4; ++j) v = fmaxf(v, acc[ai][bj][m][n][j]);
                v = fmaxf(v, __shfl_xor(v, 16)); v = fmaxf(v, __shfl_xor(v, 32));
                if (fq == 0) tabM[lr * 4 + wc] = v; }
        asm volatile("s_waitcnt lgkmcnt(0)" ::: "memory"); __builtin_amdgcn_s_barrier(); asm volatile("" ::: "memory");
        float e[2][4][16];
#pragma unroll
        for (int ai = 0; ai < 2; ++ai)
#pragma unroll
            for (int m = 0; m < 4; ++m) { const int lr = ai * HALF + wr * 64 + m * 16 + fr;
                const f32x4 t = *(const PG8_LAS f32x4*)(tabM + lr * 4); const float rm = fmaxf(fmaxf(t.x, t.y), fmaxf(t.z, t.w)); mx[ai][m] = rm;
                float s = 0.f;
#pragma unroll
                for (int bj = 0; bj < 2; ++bj)
#pragma unroll
                    for (int n = 0; n < 2; ++n)
#pragma unroll
                        for (int j = 0; j < 4; ++j) { const float p = __builtin_amdgcn_exp2f((acc[ai][bj][m][n][j] - rm) * c2[ai][m]); e[ai][m][bj * 8 + n * 4 + j] = p; s += p; }
                s += __shfl_xor(s, 16); s += __shfl_xor(s, 32);
                if (fq == 0) tabS[lr * 4 + wc] = s; }
        asm volatile("s_waitcnt lgkmcnt(0)" ::: "memory"); __builtin_amdgcn_s_barrier(); asm volatile("" ::: "memory");
#pragma unroll
        for (int ai = 0; ai < 2; ++ai)
#pragma unroll
            for (int m = 0; m < 4; ++m) { const int lr = ai * HALF + wr * 64 + m * 16 + fr;
                const f32x4 t = *(const PG8_LAS f32x4*)(tabS + lr * 4); const float inv = 1.0f / ((t.x + t.y) + (t.z + t.w));
                bf16_t* rowp = P + (size_t)(row0 + ai * HALF + m * 16) * 1024 + col0;
#pragma unroll
                for (int bj = 0; bj < 2; ++bj) { const float* q = &e[ai][m][bj * 8];
                    u32x4 w; w.x = cvt_pk_bf16(q[0] * inv, q[1] * inv); w.y = cvt_pk_bf16(q[2] * inv, q[3] * inv); w.z = cvt_pk_bf16(q[4] * inv, q[5] * inv); w.w = cvt_pk_bf16(q[6] * inv, q[7] * inv);
                    *(u32x4*)(rowp + bj * HALF) = w; } }
    }
};
struct EpiSwiglu {
    static constexpr bool PERM = true, AFTER_DRAIN = false;
    bf16_t* O; int ldc; const float* rs;
    __device__ __forceinline__ void operator()(const f32x4 (&acc)[2][2][4][2], const Unit& u, int wr, int wc, int fr, int fq) const {
        const int row0 = u.pm * BM + wr * 64 + fr, col0 = u.pn * HALF + wc * 32 + 8 * fq;
#pragma unroll
        for (int ai = 0; ai < 2; ++ai)
#pragma unroll
            for (int m = 0; m < 4; ++m) { bf16_t* rowp = O + (size_t)(row0 + ai * HALF + m * 16) * ldc + col0; float o[8];
                const float sc = 1.0f / sqrtf(rs[row0 + ai * HALF + m * 16] * (1.0f / 2048.0f) + 1e-6f);
#pragma unroll
                for (int n = 0; n < 2; ++n)
#pragma unroll
                    for (int j = 0; j < 4; ++j) { const float g = acc[ai][0][m][n][j] * sc, up = acc[ai][1][m][n][j] * sc;
                        o[n * 4 + j] = g * __builtin_amdgcn_rcpf(1.0f + __builtin_amdgcn_exp2f(-1.4426950408889634f * g)) * up; }
                u32x4 w; w.x = cvt_pk_bf16(o[0], o[1]); w.y = cvt_pk_bf16(o[2], o[3]); w.z = cvt_pk_bf16(o[4], o[5]); w.w = cvt_pk_bf16(o[6], o[7]);
                *(u32x4*)rowp = w; }
    }
};

#define PG8_ITER_SP2 do { \
            PG8_LDB(B0, 0, 0); PG8_LDB(B1, 0, 1); PG8_SCHED; PG8_LDA(At, 0, 0); PG8_STAGE(PG8_SA(1, 1), a1 + hstepA, voffA); \
            PG8_WAIT_V(8); PG8_WAIT_L(0); PG8_BAR; PG8_MMA(0, 0, At, B0); PG8_MMA(0, 1, At, B1); PG8_BAR; PG8_SCHED; \
            PG8_LDA(At, 0, 1); PG8_STAGE(PG8_SB(0, 0), b2, voffB); PG8_STAGE(PG8_SB(0, 1), b2 + hstepB, voffB); PG8_STAGE(PG8_SA(0, 0), a2, voffA); \
            PG8_WAIT_V(8); PG8_WAIT_L(0); PG8_BAR; PG8_MMA(1, 0, At, B0); PG8_MMA(1, 1, At, B1); PG8_BAR; PG8_SCHED; \
            PG8_LDB(B0, 1, 0); PG8_LDB(B1, 1, 1); PG8_SCHED; PG8_LDA(At, 1, 0); PG8_STAGE(PG8_SA(0, 1), a2 + hstepA, voffA); \
            PG8_WAIT_V(8); PG8_WAIT_L(0); PG8_BAR; PG8_MMA(0, 0, At, B0); PG8_MMA(0, 1, At, B1); PG8_BAR; PG8_SCHED; \
            PG8_LDA(At, 1, 1); PG8_STAGE(PG8_SB(1, 0), b3, voffB); PG8_STAGE(PG8_SB(1, 1), b3 + hstepB, voffB); PG8_STAGE(PG8_SA(1, 0), a3, voffA); \
            PG8_WAIT_V(8); PG8_WAIT_L(0); PG8_BAR; PG8_MMA(1, 0, At, B0); PG8_MMA(1, 1, At, B1); PG8_BAR; PG8_SCHED; \
            } while (0)
template <class Epi, class Sched, bool ALIGN_EPI = false, bool SP2 = false, bool FP8 = false, int MIXK = 0>
__device__ __forceinline__ void gemm_phase(PG8_LAS unsigned char* lds, const int K, const int lda, const int ldb, const Sched& S, const Epi& E) {
    int tid_ = threadIdx.x; asm volatile("" : "+v"(tid_));
    const int tid = tid_, wid = __builtin_amdgcn_readfirstlane(tid >> 6), lane = tid & 63, wr = wid >> 2, wc = wid & 3, fr = lane & 15, fq = lane >> 4;
    const int nt = K / BK;
    unsigned voffA[2], voffB[2];
#pragma unroll
    for (int i = 0; i < 2; ++i) { int R, C; stage_rc(tid * 16 + i * 8192, R, C); const int Rb = Epi::PERM ? ((R & ~31) + perm32(R & 31)) : R;
        voffA[i] = (unsigned)(R * lda + C) * 2u; voffB[i] = (unsigned)(Rb * ldb + C) * 2u; }
    const size_t kstep = (size_t)(BK * 2);
    const size_t hstepA = (size_t)HALF * lda * 2, hstepB = (size_t)HALF * ldb * 2;
    const unsigned ldsw = (unsigned)wid * 1024u;
    const int aoff = lds_byte(wr * 64 + fr, fq * 8), boff = lds_byte(wc * 32 + fr, fq * 8);
#define PG8_SA(b, h) (((b) * 2 + (h)) * HTB)
#define PG8_SB(b, h) ((4 + (b) * 2 + (h)) * HTB)
#define PG8_STAGE(bufoff, gbase, voff) do { const char* gb_ = (const char*)(gbase); asm volatile("" : "+s"(gb_)); _Pragma("unroll") for (int _i = 0; _i < 2; ++_i) { unsigned vo_ = (voff)[_i]; asm volatile("" : "+v"(vo_));     \
        __builtin_amdgcn_global_load_lds((const unsigned*)(gb_ + vo_), (PG8_LAS unsigned*)(lds + (bufoff) + ldsw + _i * 8192), 16, 0, 0); } } while (0)
#define PG8_LDA(dst, b, h) do { if constexpr (FP8 || (MIXK > 0 && PG8_F8SEL)) { _Pragma("unroll") for (int m = 0; m < 4; ++m) { const i32x4 lo_ = *(const PG8_LAS i32x4*)(lds + PG8_SA(b, h) + aoff + m * 2048), hi_ = *(const PG8_LAS i32x4*)(lds + PG8_SA(b, h) + aoff + m * 2048 + 1024); dst##8[m] = __builtin_shufflevector(lo_, hi_, 0, 1, 2, 3, 4, 5, 6, 7); } } \
    else { _Pragma("unroll") for (int m = 0; m < 4; ++m) _Pragma("unroll") for (int k = 0; k < 2; ++k) dst[m][k] = *(const PG8_LAS bf16x8*)(lds + PG8_SA(b, h) + aoff + m * 2048 + k * 1024); } } while (0)
#define PG8_LDB(dst, b, h) do { if constexpr (FP8 || (MIXK > 0 && PG8_F8SEL)) { _Pragma("unroll") for (int n = 0; n < 2; ++n) { const i32x4 lo_ = *(const PG8_LAS i32x4*)(lds + PG8_SB(b, h) + boff + n * 2048), hi_ = *(const PG8_LAS i32x4*)(lds + PG8_SB(b, h) + boff + n * 2048 + 1024); dst##8[n] = __builtin_shufflevector(lo_, hi_, 0, 1, 2, 3, 4, 5, 6, 7); } } \
    else { _Pragma("unroll") for (int n = 0; n < 2; ++n) _Pragma("unroll") for (int k = 0; k < 2; ++k) dst[n][k] = *(const PG8_LAS bf16x8*)(lds + PG8_SB(b, h) + boff + n * 2048 + k * 1024); } } while (0)
#define PG8_MMA(ai, bj, At, Bt) do { __builtin_amdgcn_s_setprio(1); _Pragma("unroll") for (int m = 0; m < 4; ++m) _Pragma("unroll") for (int n = 0; n < 2; ++n) { \
        if constexpr (FP8) asm volatile("v_mfma_f32_16x16x128_f8f6f4 %0, %1, %2, %0" : "+v"(acc[ai][bj][m][n]) : "v"(Bt##8[n]), "v"(At##8[m]));     \
        else if constexpr (MIXK > 0 && PG8_F8SEL) asm volatile("v_mfma_scale_f32_16x16x128_f8f6f4 %0, %1, %2, %0, %3, %4 op_sel_hi:[0,0,0]" : "+v"(acc[ai][bj][m][n]) : "v"(Bt##8[n]), "v"(At##8[m]), "v"(sclW_), "v"(sclA_)); \
        else { _Pragma("unroll") for (int k = 0; k < 2; ++k) acc[ai][bj][m][n] = __builtin_amdgcn_mfma_f32_16x16x32_bf16(Bt[n][k], At[m][k], acc[ai][bj][m][n], 0, 0, 0); } } \
        __builtin_amdgcn_s_setprio(0); } while (0)
#define PG8_WAIT_V(n) asm volatile("s_waitcnt vmcnt(" #n ")" ::: "memory")
#define PG8_WAIT_L(n) asm volatile("s_waitcnt lgkmcnt(" #n ")" ::: "memory")
#define PG8_BAR __builtin_amdgcn_s_barrier()
#define PG8_SCHED __builtin_amdgcn_sched_barrier(0)
    Unit cur, nxt; int ui = 0;
    if (!S.next(0, cur)) return;
    f32x4 acc[2][2][4][2];
#pragma unroll
    for (int a = 0; a < 2; ++a)
#pragma unroll
        for (int b = 0; b < 2; ++b)
#pragma unroll
            for (int m = 0; m < 4; ++m)
#pragma unroll
                for (int n = 0; n < 2; ++n) acc[a][b][m][n] = (f32x4){0.f, 0.f, 0.f, 0.f};
    bf16x8 At[4][2], B0[2][2], B1[2][2];
    const int sclW_ = 0x7A7A7A7A, sclA_ = 0x7B7B7B7B;
    i32x8 At8[4], B08[2], B18[2];
    const char* cA = cur.a; const char* cB = cur.b;
    S.a_ready(cur);
    if constexpr (SP2) {
        PG8_STAGE(PG8_SB(0, 0), cB, voffB); PG8_STAGE(PG8_SB(0, 1), cB + hstepB, voffB); PG8_STAGE(PG8_SA(0, 0), cA, voffA); PG8_STAGE(PG8_SA(0, 1), cA + hstepA, voffA);
        if (wr == 1) PG8_BAR;
        PG8_WAIT_V(2); PG8_BAR;
        PG8_STAGE(PG8_SB(1, 0), cB + kstep, voffB); PG8_STAGE(PG8_SA(1, 0), cA + kstep, voffA); PG8_STAGE(PG8_SB(1, 1), cB + hstepB + kstep, voffB);
        PG8_WAIT_V(6); PG8_BAR;
    } else {
        PG8_STAGE(PG8_SB(0, 0), cB, voffB); PG8_STAGE(PG8_SA(0, 0), cA, voffA); PG8_STAGE(PG8_SB(0, 1), cB + hstepB, voffB); PG8_STAGE(PG8_SA(0, 1), cA + hstepA, voffA);
        if (wr == 1) PG8_BAR;
        PG8_WAIT_V(4); PG8_BAR;
        PG8_STAGE(PG8_SB(1, 0), cB + kstep, voffB); PG8_STAGE(PG8_SA(1, 0), cA + kstep, voffA); PG8_STAGE(PG8_SB(1, 1), cB + hstepB + kstep, voffB);
        PG8_WAIT_V(6); PG8_BAR;
    }
    for (;;) {
        const bool has_next = S.next(ui + 1, nxt);
        const char* nA = has_next ? nxt.a : cA; const char* nB = has_next ? nxt.b : cB;
#define PG8_TPTRS(cA, cB, nA, nB) \
            const bool last = (t == nt - 2); \
            const char* a1 = cA + (size_t)(t + 1) * kstep; \
            const char* a2 = last ? nA : cA + (size_t)(t + 2) * kstep; const char* b2 = last ? nB : cB + (size_t)(t + 2) * kstep; \
            const char* a3 = a2 + kstep; const char* b3 = b2 + kstep; \
            if (last && has_next) S.a_ready(nxt);
        if constexpr (MIXK > 0) {
            for (int t = 0; t < MIXK; t += 2) { PG8_TPTRS(cA, cB, nA, nB)
#define PG8_F8SEL false
                PG8_ITER_SP2;
#undef PG8_F8SEL
            }
            const char* cA2 = cA; const char* cB2 = cB; const char* nA2 = nA; const char* nB2 = nB;
            asm volatile("" : "+s"(cA2), "+s"(cB2), "+s"(nA2), "+s"(nB2));
            for (int t = MIXK; t < nt; t += 2) { PG8_TPTRS(cA2, cB2, nA2, nB2)
#define PG8_F8SEL true
                PG8_ITER_SP2;
#undef PG8_F8SEL
            }
        } else
        for (int t = 0; t < nt; t += 2) {
            const bool last = (t == nt - 2);
            const char* a1 = cA + (size_t)(t + 1) * kstep;
            const char* a2 = last ? nA : cA + (size_t)(t + 2) * kstep; const char* b2 = last ? nB : cB + (size_t)(t + 2) * kstep;
            const char* a3 = a2 + kstep; const char* b3 = b2 + kstep;
            if (last && has_next) S.a_ready(nxt);
            if constexpr (SP2) {
#define PG8_F8SEL false
                PG8_ITER_SP2;
#undef PG8_F8SEL
            } else {
#define PG8_F8SEL false
            PG8_LDB(B0, 0, 0); PG8_SCHED; PG8_LDA(At, 0, 0); PG8_STAGE(PG8_SA(1, 1), a1 + hstepA, voffA);
            PG8_WAIT_L(8); PG8_BAR; PG8_WAIT_L(0); PG8_MMA(0, 0, At, B0); PG8_BAR; PG8_SCHED;
            PG8_LDB(B1, 0, 1); PG8_STAGE(PG8_SB(0, 0), b2, voffB);
            PG8_BAR; PG8_WAIT_L(0); PG8_MMA(0, 1, At, B1); PG8_BAR;
            PG8_LDA(At, 0, 1); PG8_STAGE(PG8_SA(0, 0), a2, voffA);
            PG8_BAR; PG8_WAIT_L(0); PG8_MMA(1, 0, At, B0); PG8_BAR; PG8_SCHED;
            PG8_STAGE(PG8_SB(0, 1), b2 + hstepB, voffB);
            PG8_WAIT_V(6); PG8_BAR; PG8_MMA(1, 1, At, B1); PG8_BAR;
            PG8_LDB(B0, 1, 0); PG8_SCHED; PG8_LDA(At, 1, 0); PG8_STAGE(PG8_SA(0, 1), a2 + hstepA, voffA);
            PG8_WAIT_L(8); PG8_BAR; PG8_WAIT_L(0); PG8_MMA(0, 0, At, B0); PG8_BAR; PG8_SCHED;
            PG8_LDB(B1, 1, 1); PG8_STAGE(PG8_SB(1, 0), b3, voffB);
            PG8_BAR; PG8_WAIT_L(0); PG8_MMA(0, 1, At, B1); PG8_BAR;
            PG8_LDA(At, 1, 1); PG8_STAGE(PG8_SA(1, 0), a3, voffA);
            PG8_BAR; PG8_WAIT_L(0); PG8_MMA(1, 0, At, B0); PG8_BAR; PG8_SCHED;
            PG8_STAGE(PG8_SB(1, 1), b3 + hstepB, voffB);
            PG8_WAIT_V(6); PG8_BAR; PG8_MMA(1, 1, At, B1); PG8_BAR;
#undef PG8_F8SEL
            }
        }
        if constexpr (ALIGN_EPI) { if (wr == 0) PG8_BAR; }
        if constexpr (FP8 || MIXK > 0) asm volatile("s_nop 15\n\ts_nop 15" ::: "memory");
        if constexpr (!Epi::AFTER_DRAIN) { E(acc, cur, wr, wc, fr, fq); S.done(cur); }
        if (!has_next) break;
#pragma unroll
        for (int a = 0; a < 2; ++a)
#pragma unroll
            for (int b = 0; b < 2; ++b)
#pragma unroll
                for (int m = 0; m < 4; ++m)
#pragma unroll
                    for (int n = 0; n < 2; ++n) acc[a][b][m][n] = (f32x4){0.f, 0.f, 0.f, 0.f};
        cur = nxt; cA = nA; cB = nB; ++ui;
        if constexpr (ALIGN_EPI) { if (wr == 1) PG8_BAR; }
    }
    PG8_WAIT_V(0);
    if constexpr (!ALIGN_EPI) { if (wr == 0) PG8_BAR; }
    PG8_BAR;
    if constexpr (Epi::AFTER_DRAIN) { E.fused(acc, cur, wr, wc, fr, fq, lds, wid, lane); S.done(cur); }
#undef PG8_SA
#undef PG8_SB
#undef PG8_STAGE
#undef PG8_LDA
#undef PG8_LDB
#undef PG8_MMA
#undef PG8_WAIT_V
#undef PG8_WAIT_L
#undef PG8_BAR
#undef PG8_SCHED
}
}

constexpr int DM = 2048, NBATCH = 4, SEQ = 4096, MTOK = NBATCH * SEQ, DEPTH = 2, NMEM = 256, MMEM = NBATCH * NMEM;
constexpr int D_IN = 7264, LDP = 7424;
constexpr int C_GQ = 0, C_GK = 512, C_GV = 1024, C_GR = 2048, C_DQ = 3072, C_DK = 4096, C_DV = 5120, C_IQ = 6144, C_GZ = 7168, C_IK = 7184, C_IW = 7248;
constexpr int DFF = 5632;
constexpr float EPS = 1e-6f;
constexpr int NWAVES = 8, NTHR = 512;
constexpr int MIXP = 1536; constexpr float FP8_ODSA_SCALE = 16.0f, FP8_WOUT_SCALE = 32.0f;
#ifndef FP8_FFN_OUT
#define FP8_FFN_OUT 3
#endif
#ifndef FP8_LAYERS
#define FP8_LAYERS 3
#endif
#ifndef FP8_INPROJ
#define FP8_INPROJ 3
#endif
#ifndef FP8_IN_T0_L0
#define FP8_IN_T0_L0 12
#endif
#ifndef FP8_IN_T0_L1
#define FP8_IN_T0_L1 4
#endif
#define FP8_IN_T0(l) ((l) == 0 ? FP8_IN_T0_L0 : FP8_IN_T0_L1)
constexpr int FP8_IN_ROWS = 6144; constexpr float FP8_WIN_SCALE = 32.0f;
constexpr float FP8_WFI_SCALE = 32.0f, FP8_WFO_SCALE = 64.0f, FP8_ACT_SCALE = 8.0f;

constexpr size_t MiB = 1u << 20;
constexpr size_t WS_CTL = 0, CTL_ZERO_BYTES = 1 * MiB;
constexpr size_t WS_WIN = 1 * MiB;
constexpr size_t WS_WOUT = WS_WIN + 29 * MiB;
constexpr size_t WS_WXQ = WS_WOUT + 8 * MiB;
constexpr size_t WS_WXKV = WS_WXQ + 8 * MiB;
constexpr size_t WS_WXO = WS_WXKV + 16 * MiB;
constexpr size_t WS_WFI = WS_WXO + 8 * MiB;
constexpr size_t WS_WFO = WS_WFI + 44 * MiB;
constexpr size_t WS_MEMN = WS_WFO + 22 * MiB;
constexpr size_t WS_KV = WS_MEMN + 4 * MiB;
constexpr size_t WS_AT = WS_KV + 8 * MiB;
constexpr size_t WS_BT2 = WS_AT + 16 * MiB;
constexpr size_t WS_PROJ = WS_BT2 + 16 * MiB;
constexpr size_t WS_ACT = WS_PROJ;
constexpr size_t WS_LOGIT = WS_PROJ;
constexpr size_t WS_PROB = WS_PROJ + 64 * MiB;
constexpr size_t WS_BUFA = WS_PROJ + 232 * MiB;
constexpr size_t WS_BUFB = WS_BUFA + 64 * MiB;
constexpr size_t WS_SCR = WS_BUFB;
constexpr size_t WS_PART = WS_BUFB + 128 * MiB;
constexpr size_t WS_DEC = WS_PART + 2 * MiB;
constexpr size_t WS_XB = WS_DEC + 1 * MiB;
constexpr size_t WS_SS = WS_XB + 64 * MiB;
constexpr size_t WS_IKC = WS_SS + 1 * MiB;
constexpr size_t WS_END = WS_IKC + 2 * MiB;
constexpr size_t DO_BCUM = 0, DO_MASK = 32 * MiB, DO_K8 = 40 * MiB, DO_V8T = 56 * MiB;
static_assert(WS_END <= 700 * MiB, "workspace map");
constexpr int CW_TMO = 0, CW_BAR = 4096, CW_PANEL = 16384;
#ifndef FUSE_SOFTMAX
#define FUSE_SOFTMAX 1
#endif
#ifndef FUSE_NORM
#define FUSE_NORM 0
#endif

constexpr int RING_OFF = 0, RING_BYTES = 131072;
constexpr int LDSCTL_OFF = RING_BYTES, MISC_OFF = LDSCTL_OFF + 320;
constexpr int LDS_BYTES = 147456;

#define RLX_AGENT __ATOMIC_RELAXED, __HIP_MEMORY_SCOPE_AGENT
#define LDS_WAIT() asm volatile("s_waitcnt lgkmcnt(0)" ::: "memory")
#define VM_WAIT() asm volatile("s_waitcnt vmcnt(0)" ::: "memory")
__device__ __forceinline__ unsigned f2bf(float f) { unsigned u = __builtin_bit_cast(unsigned, f); return (u + 0x7fffu + ((u >> 16) & 1u)) >> 16; }
__device__ __forceinline__ unsigned pk2(float lo, float hi) { return f2bf(lo) | (f2bf(hi) << 16); }
__device__ __forceinline__ unsigned pk2h(float lo, float hi) { unsigned r; asm("v_cvt_pk_bf16_f32 %0, %1, %2" : "=v"(r) : "v"(lo), "v"(hi)); return r; }
__device__ __forceinline__ float bf2f(unsigned short b) { return __builtin_bit_cast(float, (unsigned)b << 16); }
__device__ __forceinline__ float bflo(unsigned w) { return __builtin_bit_cast(float, w << 16); }
__device__ __forceinline__ float bfhi(unsigned w) { return __builtin_bit_cast(float, w & 0xffff0000u); }

#define XB_TMO      128
#define XB_XCNT(j)  (256  + 64 * (j))
#define XB_XSUB(j)  (1280 + 64 * (j))
#define XB_XGEN(j)  (2304 + 64 * (j))
#define XB_TOP      3328
#define XB_TOPGEN   3392
#define XCD_BAR_WORDS 3456
#define XB_SPIN_CAP (1u << 18)

__device__ __forceinline__ unsigned xb_ld(unsigned* p)              { return __hip_atomic_load(p, __ATOMIC_RELAXED, __HIP_MEMORY_SCOPE_AGENT); }
__device__ __forceinline__ unsigned xb_add(unsigned* p, unsigned v) { return __hip_atomic_fetch_add(p, v, __ATOMIC_RELAXED, __HIP_MEMORY_SCOPE_AGENT); }
__device__ __forceinline__ unsigned xb_xcc_id() { return (unsigned)__builtin_amdgcn_s_getreg((3 << 11) | 20) & 0xFu; }
#define XB_SPIN(cond, bar) do { unsigned _sp = 0; while (cond) { __builtin_amdgcn_s_sleep(1); \
    if ((++_sp & 255u) == 0u) { if (xb_ld(&(bar)[XB_TMO])) break; if (_sp > XB_SPIN_CAP) { atomicAdd(&(bar)[XB_TMO], 1u); break; } } } } while (0)

struct XcdBarrier {
    unsigned* bar; unsigned x;
    volatile LAS unsigned* st;
};

__device__ __forceinline__ XcdBarrier xcd_barrier_post(unsigned* bar, volatile LAS unsigned* st) {
    XcdBarrier b; b.bar = bar; b.x = xb_xcc_id(); b.st = st;
    if (threadIdx.x == 0) (void)xb_add(&bar[XB_XCNT(b.x)], 1u);
    return b;
}
__device__ __forceinline__ void xcd_barrier_complete(unsigned* bar, unsigned x, unsigned& nloc, unsigned& nx) {
    const unsigned G = gridDim.x * gridDim.y * gridDim.z;
    unsigned sum, cnt, mine, sp = 0u;
    for (;;) {
        sum = 0u; cnt = 0u; mine = 0u;
#pragma unroll
        for (unsigned j = 0; j < 16; ++j) { const unsigned c = xb_ld(&bar[XB_XCNT(j)]); sum += c; cnt += (c > 0u) ? 1u : 0u; mine = (j == x) ? c : mine; }
        if (sum == G) break;
        __builtin_amdgcn_s_sleep(1);
        if ((++sp & 255u) == 0u) { if (xb_ld(&bar[XB_TMO])) break; if (sp > XB_SPIN_CAP) { atomicAdd(&bar[XB_TMO], 1u); break; } }
    }
    nloc = mine > 0u ? mine : 1u; nx = cnt > 0u ? cnt : 1u;
}

__device__ __forceinline__ void xcd_barrier(const XcdBarrier& b) {
    asm volatile("s_waitcnt vmcnt(0)" ::: "memory");
    __syncthreads();
    if (threadIdx.x == 0) {
        unsigned* bar = b.bar;
        __builtin_amdgcn_s_waitcnt(0);
        unsigned nloc = b.st[0], nx = b.st[1];
        if (nloc == 0u) { xcd_barrier_complete(bar, b.x, nloc, nx); b.st[0] = nloc; b.st[1] = nx; }
        const unsigned old = xb_add(&bar[XB_XSUB(b.x)], 1u);
        const unsigned gen = old / nloc;
        if (old + 1u == (gen + 1u) * nloc) {
            __builtin_amdgcn_fence(__ATOMIC_RELEASE, "agent");
            asm volatile("s_waitcnt vmcnt(0)" ::: "memory");
            const unsigned og = xb_add(&bar[XB_TOP], 1u);
            const unsigned tg = og / nx;
            if (og + 1u == (tg + 1u) * nx) xb_add(&bar[XB_TOPGEN], 1u);
            else XB_SPIN(xb_ld(&bar[XB_TOPGEN]) == tg, bar);
            __builtin_amdgcn_fence(__ATOMIC_ACQUIRE, "agent");
            xb_add(&bar[XB_XGEN(b.x)], 1u);
            asm volatile("s_waitcnt vmcnt(0)" ::: "memory");
        } else {
            XB_SPIN(xb_ld(&bar[XB_XGEN(b.x)]) == gen, bar);
            __builtin_amdgcn_fence(__ATOMIC_ACQUIRE, "agent");
            asm volatile("s_waitcnt vmcnt(0)" ::: "memory");
        }
    }
    __syncthreads();
}

struct Frame {
    LAS unsigned char* lds;
    volatile LAS unsigned* MISC;
    gu32* ctl;
    int tid, lane, wave;
    int vcu, G;
    unsigned char* ws;
};
template <int CTRL> __device__ __forceinline__ float dpp_mov(float v) { return __builtin_bit_cast(float, __builtin_amdgcn_update_dpp(0, __builtin_bit_cast(int, v), CTRL, 0xf, 0xf, true)); }
__device__ __forceinline__ float rl(float v, int lane) { return __builtin_bit_cast(float, __builtin_amdgcn_readlane(__builtin_bit_cast(int, v), lane)); }
__device__ __forceinline__ float wave_sum(float v) {
    v += dpp_mov<0xB1>(v); v += dpp_mov<0x4E>(v); v += dpp_mov<0x141>(v); v += dpp_mov<0x140>(v);
    return (rl(v, 0) + rl(v, 16)) + (rl(v, 32) + rl(v, 48));
}
__device__ __forceinline__ float wave_max(float v) {
    v = fmaxf(v, dpp_mov<0xB1>(v)); v = fmaxf(v, dpp_mov<0x4E>(v)); v = fmaxf(v, dpp_mov<0x141>(v)); v = fmaxf(v, dpp_mov<0x140>(v));
    return fmaxf(fmaxf(rl(v, 0), rl(v, 16)), fmaxf(rl(v, 32), rl(v, 48)));
}

template <int MODE> __device__ __forceinline__ int dest_row(int n) {
    if (MODE == 1) { if (n < 2048) return n; if (n < 2064) return C_GZ + (n - 2048); if (n < 7184) return n - 16; if (n < 7248) return C_IK + (n - 7184); return C_IW + (n - 7248); }
    if (MODE == 2) { const int s = n >= DFF ? 1 : 0, j = n - s * DFF; return 256 * (j >> 7) + 128 * s + (j & 127); }
    return n;
}
__device__ __forceinline__ unsigned pk4_fp8(float a, float b, float c2, float d) { unsigned w = 0u; w = __builtin_amdgcn_cvt_pk_fp8_f32(a, b, w, false); w = __builtin_amdgcn_cvt_pk_fp8_f32(c2, d, w, true); return w; }
template <int MODE, bool FP8 = false, bool MIXED = false> __device__ __forceinline__ void p0_transpose_item(const float* W, int K, int N, void* WTv, LAS float* scr, int item, int lane, const float* gk = nullptr, float wscale = 1.0f) {
    const int nblk = N / 32, kb = item / nblk, nb = item % nblk, k0 = 64 * kb, n0 = 32 * nb;
    float wv[32];
#pragma unroll
    for (int i = 0; i < 32; ++i) wv[i] = W[(size_t)(k0 + 2 * i + (lane >> 5)) * N + n0 + (lane & 31)];
#pragma unroll
    for (int i = 0; i < 32; ++i) scr[(2 * i + (lane >> 5)) * 33 + (lane & 31)] = wv[i];
    LDS_WAIT(); asm volatile("" ::: "memory");
    const int c = lane & 7;
    const float ws1 = MIXED ? 1.0f : wscale;
    f32x4 ga = {ws1, ws1, ws1, ws1}, gb = ga;
    if (gk) { ga = *(const f32x4*)(gk + k0 + 8 * c) * ws1; gb = *(const f32x4*)(gk + k0 + 8 * c + 4) * ws1; }
#pragma unroll
    for (int j = 0; j < 4; ++j) { const int n = (lane >> 3) + 8 * j; const LAS float* s = scr + (8 * c) * 33 + n;
        const float v0 = s[0 * 33] * ga.x, v1 = s[1 * 33] * ga.y, v2 = s[2 * 33] * ga.z, v3 = s[3 * 33] * ga.w, v4 = s[4 * 33] * gb.x, v5 = s[5 * 33] * gb.y, v6 = s[6 * 33] * gb.z, v7 = s[7 * 33] * gb.w;
        if constexpr (MIXED) { const int dr = dest_row<MODE>(n0 + n);
            if (dr < FP8_IN_ROWS && dr >= FP8_IN_T0_L1 * 256) { u32x2 o; o.x = pk4_fp8(v0 * wscale, v1 * wscale, v2 * wscale, v3 * wscale); o.y = pk4_fp8(v4 * wscale, v5 * wscale, v6 * wscale, v7 * wscale); *(GAS u32x2*)((unsigned char*)WTv + (size_t)FP8_IN_T0_L1 * 256 * K + (size_t)dr * K + k0 + 8 * c) = o; }
            else { u32x4 o; o.x = pk2h(v0, v1); o.y = pk2h(v2, v3); o.z = pk2h(v4, v5); o.w = pk2h(v6, v7); *(GAS u32x4*)((bf16*)WTv + (size_t)dr * K + k0 + 8 * c) = o; } }
        else if constexpr (FP8) { u32x2 o; o.x = pk4_fp8(v0, v1, v2, v3); o.y = pk4_fp8(v4, v5, v6, v7);
            *(GAS u32x2*)((unsigned char*)WTv + (size_t)dest_row<MODE>(n0 + n) * K + k0 + 8 * c) = o; }
        else { u32x4 o; o.x = pk2h(v0, v1); o.y = pk2h(v2, v3); o.z = pk2h(v4, v5); o.w = pk2h(v6, v7);
            *(GAS u32x4*)((bf16*)WTv + (size_t)dest_row<MODE>(n0 + n) * K + k0 + 8 * c) = o; } }
    LDS_WAIT(); asm volatile("" ::: "memory");
}
__device__ __forceinline__ void rms_row_to_bf16(const float* xrow, const float* g, bf16* orow, int lane) {
    f32x4 v[8]; float s = 0.f;
#pragma unroll
    for (int j = 0; j < 4; ++j) { const float* p = xrow + 8 * lane + 512 * j; v[2 * j] = *(const f32x4*)p; v[2 * j + 1] = *(const f32x4*)(p + 4); }
#pragma unroll
    for (int j = 0; j < 8; ++j) s += (v[j].x * v[j].x + v[j].y * v[j].y) + (v[j].z * v[j].z + v[j].w * v[j].w);
    const float rstd = 1.0f / sqrtf(wave_sum(s) * (1.0f / DM) + EPS);
#pragma unroll
    for (int j = 0; j < 4; ++j) { const float* gp = g + 8 * lane + 512 * j; const f32x4 g0 = *(const f32x4*)gp, g1 = *(const f32x4*)(gp + 4); const f32x4 a = v[2 * j] * rstd * g0, b = v[2 * j + 1] * rstd * g1;
        u32x4 o; o.x = pk2h(a.x, a.y); o.y = pk2h(a.z, a.w); o.z = pk2h(b.x, b.y); o.w = pk2h(b.z, b.w);
        *(u32x4*)(orow + 8 * lane + 512 * j) = o; }
}
struct TDesc { const float* src; const float* gk; unsigned char* dst; int N, K, k0, n0, mode, kind, t0; float wscale; };
__device__ __forceinline__ int dest_row_rt(int mode, int n) { return mode == 1 ? dest_row<1>(n) : (mode == 2 ? dest_row<2>(n) : n); }
__device__ __forceinline__ void t_load(const TDesc& d, f32x4 (&wv)[8], int lane) {
#pragma unroll
    for (int i = 0; i < 8; ++i) wv[i] = __builtin_nontemporal_load((const f32x4*)(d.src + (size_t)(d.k0 + 8 * i + (lane >> 3)) * d.N + d.n0 + 4 * (lane & 7)));
}
__device__ __forceinline__ void t_finish(const TDesc& d, const f32x4 (&wv)[8], LAS float* scr, int lane) {
#pragma unroll
    for (int i = 0; i < 8; ++i) { LAS float* p = scr + (8 * i + (lane >> 3)) * 33 + 4 * (lane & 7); p[0] = wv[i].x; p[1] = wv[i].y; p[2] = wv[i].z; p[3] = wv[i].w; }
    LDS_WAIT(); asm volatile("" ::: "memory");
    const int c = lane & 7, K = d.K, k0 = d.k0;
    const float ws1 = d.kind == 1 ? d.wscale : 1.0f;
    f32x4 ga = {ws1, ws1, ws1, ws1}, gb = ga;
    if (d.gk) { ga = *(const f32x4*)(d.gk + k0 + 8 * c) * ws1; gb = *(const f32x4*)(d.gk + k0 + 8 * c + 4) * ws1; }
#pragma unroll
    for (int j = 0; j < 4; ++j) { const int n = (lane >> 3) + 8 * j; const LAS float* s = scr + (8 * c) * 33 + n;
        const float v0 = s[0 * 33] * ga.x, v1 = s[1 * 33] * ga.y, v2 = s[2 * 33] * ga.z, v3 = s[3 * 33] * ga.w, v4 = s[4 * 33] * gb.x, v5 = s[5 * 33] * gb.y, v6 = s[6 * 33] * gb.z, v7 = s[7 * 33] * gb.w;
        const int dr = dest_row_rt(d.mode, d.n0 + n);
        if (d.kind == 3) {
            if (k0 < 1024) { u32x4 o; o.x = pk2h(v0, v1); o.y = pk2h(v2, v3); o.z = pk2h(v4, v5); o.w = pk2h(v6, v7); *(GAS u32x4*)(d.dst + (size_t)dr * (2 * MIXP) + (size_t)(k0 + 8 * c) * 2) = o; }
            else { const float w = d.wscale; u32x2 o; o.x = pk4_fp8(v0 * w, v1 * w, v2 * w, v3 * w); o.y = pk4_fp8(v4 * w, v5 * w, v6 * w, v7 * w); *(GAS u32x2*)(d.dst + (size_t)dr * (2 * MIXP) + 2048 + (k0 - 1024) + 8 * c) = o; } }
        else if (d.kind == 1) { u32x2 o; o.x = pk4_fp8(v0, v1, v2, v3); o.y = pk4_fp8(v4, v5, v6, v7); *(GAS u32x2*)(d.dst + (size_t)dr * K + k0 + 8 * c) = o; }
        else if (d.kind == 2 && dr < FP8_IN_ROWS && dr >= d.t0 * 256) { const float w = d.wscale; u32x2 o; o.x = pk4_fp8(v0 * w, v1 * w, v2 * w, v3 * w); o.y = pk4_fp8(v4 * w, v5 * w, v6 * w, v7 * w);
            *(GAS u32x2*)(d.dst + (size_t)d.t0 * 256 * K + (size_t)dr * K + k0 + 8 * c) = o; }
        else { u32x4 o; o.x = pk2h(v0, v1); o.y = pk2h(v2, v3); o.z = pk2h(v4, v5); o.w = pk2h(v6, v7); *(GAS u32x4*)((bf16*)d.dst + (size_t)dr * K + k0 + 8 * c) = o; } }
    LDS_WAIT(); asm volatile("" ::: "memory");
}
struct P0Args { const float *x, *mem, *gains, *w_in, *w_out, *w_xq, *w_xkv, *w_xo, *w_fi, *w_fo; unsigned char* ws; int layer, fp8, fp8in, fp8fo; };
__device__ __forceinline__ void p0_prologue(Frame& F, const P0Args& a) {
    LAS float* scr = (LAS float*)(F.lds + RING_OFF + F.wave * 16384);
    int lane_ = threadIdx.x & 63; asm volatile("" : "+v"(lane_));
    const int gw = F.vcu * NWAVES + F.wave, NGW = F.G * NWAVES, lane = lane_;
    unsigned char* ws = a.ws;
    constexpr int I_IN = (DM / 64) * (D_IN / 32), I_SQ = (DM / 64) * (DM / 32), I_KV = (DM / 64) * (2 * DM / 32), I_FI = (DM / 64) * (2 * DFF / 32), I_FO = (DFF / 64) * (DM / 32);
#ifndef REP_P0
#define REP_P0 1
#endif
    for (int rp0_ = 0; rp0_ < REP_P0; ++rp0_) {
        constexpr int E0 = I_FI, E1 = E0 + I_IN, E2 = E1 + I_FO, E3 = E2 + I_KV, E4 = E3 + I_SQ, E5 = E4 + I_SQ;
        auto decode = [&](int it, TDesc& d) {
            int li; d.gk = nullptr; d.wscale = 1.0f; d.mode = 0; d.kind = 0; d.t0 = 0;
            if (it < E0) { li = it; d.src = a.w_fi; d.N = 2 * DFF; d.K = DM; d.dst = ws + WS_WFI; d.mode = 2; d.gk = a.gains + (a.layer * 7 + 4) * DM; if (a.fp8) { d.kind = 1; d.wscale = FP8_WFI_SCALE; } }
            else if (it < E1) { li = it - E0; d.src = a.w_in; d.N = D_IN; d.K = DM; d.dst = ws + WS_WIN; d.mode = 1; d.gk = a.gains + (a.layer * 7 + 0) * DM; if (a.fp8in) { d.kind = 2; d.wscale = FP8_WIN_SCALE; d.t0 = FP8_IN_T0(a.layer); } }
            else if (it < E2) { li = it - E1; d.src = a.w_fo; d.N = DM; d.K = DFF; d.dst = ws + WS_WFO; if (a.fp8fo) { d.kind = 1; d.wscale = FP8_WFO_SCALE; } }
            else if (it < E3) { li = it - E2; d.src = a.w_xkv; d.N = 2 * DM; d.K = DM; d.dst = ws + WS_WXKV; }
            else if (it < E4) { li = it - E3; d.src = a.w_out; d.N = DM; d.K = DM; d.dst = ws + WS_WOUT; d.kind = 3; d.wscale = FP8_WOUT_SCALE; }
            else { li = it - E4; d.src = a.w_xo; d.N = DM; d.K = DM; d.dst = ws + WS_WXO; }
            const int nblk = d.N / 32; d.k0 = 64 * (li / nblk); d.n0 = 32 * (li % nblk); };
        TDesc d0, d1, d2, d3; f32x4 w0[8], w1[8], w2[8], w3[8];
#define P0_TL(k, i) do { const int i_ = (i); if (i_ < E5) { decode(i_, d##k); t_load(d##k, w##k, lane); } } while (0)
        int it = gw;
        P0_TL(0, it); P0_TL(1, it + NGW); P0_TL(2, it + 2 * NGW);
        while (it < E5) {
            P0_TL(3, it + 3 * NGW); t_finish(d0, w0, scr, lane); if (it + NGW >= E5) break;
            P0_TL(0, it + 4 * NGW); t_finish(d1, w1, scr, lane); if (it + 2 * NGW >= E5) break;
            P0_TL(1, it + 5 * NGW); t_finish(d2, w2, scr, lane); if (it + 3 * NGW >= E5) break;
            P0_TL(2, it + 6 * NGW); t_finish(d3, w3, scr, lane); it += 4 * NGW;
        }
#undef P0_TL
    }
    for (int r = gw; r < DM; r += NGW) { const float* src = a.w_xq + (size_t)r * DM; bf16* dst = (bf16*)(ws + WS_WXQ) + (size_t)r * DM;
        const float gr = a.gains[(a.layer * 7 + 2) * DM + r];
#pragma unroll
        for (int j = 0; j < 4; ++j) { const float* p = src + 8 * lane + 512 * j; const f32x4 v0 = *(const f32x4*)p, v1 = *(const f32x4*)(p + 4);
            u32x4 o; o.x = pk2h(v0.x * gr, v0.y * gr); o.y = pk2h(v0.z * gr, v0.w * gr); o.z = pk2h(v1.x * gr, v1.y * gr); o.w = pk2h(v1.z * gr, v1.w * gr); *(u32x4*)(dst + 8 * lane + 512 * j) = o; } }
    for (int r = D_IN + gw; r < LDP; r += NGW) { bf16* dst = (bf16*)(ws + WS_WIN) + (size_t)r * DM;
#pragma unroll
        for (int j = 0; j < 4; ++j) *(u32x4*)(dst + 8 * lane + 512 * j) = (u32x4){0u, 0u, 0u, 0u}; }
    for (int r = gw; r < MMEM; r += NGW) rms_row_to_bf16(a.mem + (size_t)r * DM, a.gains + (a.layer * 7 + 6) * DM, (bf16*)(ws + WS_MEMN) + (size_t)r * DM, lane);
    for (int rp1_ = 0; rp1_ < REP_P0; ++rp1_)
    if (a.layer == 0) for (int r0 = gw; r0 < MTOK; r0 += 2 * NGW) {
        f32x4 xv[2][8]; const bool two = r0 + NGW < MTOK;
#pragma unroll
        for (int q = 0; q < 2; ++q) { const float* xr = a.x + (size_t)((q && two) ? r0 + NGW : r0) * DM;
#pragma unroll
            for (int j = 0; j < 4; ++j) { const float* p = xr + 8 * lane + 512 * j; xv[q][2 * j] = __builtin_nontemporal_load((const f32x4*)p); xv[q][2 * j + 1] = __builtin_nontemporal_load((const f32x4*)(p + 4)); } }
#pragma unroll
        for (int q = 0; q < 2; ++q) { if (q == 1 && !two) break; const int r = r0 + q * NGW; bf16* orow = (bf16*)(ws + WS_XB) + (size_t)r * DM; float s = 0.f;
#pragma unroll
            for (int j = 0; j < 4; ++j) { const f32x4 v0 = xv[q][2 * j], v1 = xv[q][2 * j + 1];
                s += (v0.x * v0.x + v0.y * v0.y) + (v0.z * v0.z + v0.w * v0.w) + (v1.x * v1.x + v1.y * v1.y) + (v1.z * v1.z + v1.w * v1.w);
                u32x4 o; o.x = pk2h(v0.x, v0.y); o.y = pk2h(v0.z, v0.w); o.z = pk2h(v1.x, v1.y); o.w = pk2h(v1.z, v1.w); *(u32x4*)(orow + 8 * lane + 512 * j) = o;
                if (a.fp8in) { u32x2 o8; o8.x = pk4_fp8(v0.x, v0.y, v0.z, v0.w); o8.y = pk4_fp8(v1.x, v1.y, v1.z, v1.w); *(u32x2*)(ws + WS_BUFB + (size_t)r * DM + 8 * lane + 512 * j) = o8; } }
            s = wave_sum(s); if (lane == 0) ((float*)(ws + WS_SS))[r] = s; } }
}

__device__ __forceinline__ void norm_rows(int row_lo, int row_hi, int widx, int nw, bf16* xb, const bf16* y, const float* part, const float* g_post, float* ss, float* outf, unsigned char* xb8) {
    int lane_ = threadIdx.x & 63; asm volatile("" : "+v"(lane_));
    const int gw = row_lo + widx, NGW = nw, lane = lane_, MT = row_hi;
    constexpr int NQ = 4;
    for (int r0 = gw; r0 < MT; r0 += NQ * NGW) {
        u32x4 xw[NQ][4], yw[NQ][4]; float ps[NQ];
#pragma unroll
        for (int q = 0; q < NQ; ++q) { const int rq = r0 + q * NGW; const int r = rq < MT ? rq : r0; ps[q] = lane < 32 ? part[(size_t)r * 32 + lane] : 0.f;
#pragma unroll
            for (int j = 0; j < 4; ++j) { const int c = 8 * lane + 512 * j; xw[q][j] = *(const u32x4*)(xb + (size_t)r * DM + c); yw[q][j] = *(const u32x4*)(y + (size_t)r * DM + c); } }
#pragma unroll
        for (int q = 0; q < NQ; ++q) { const int r = r0 + q * NGW; if (r >= MT) break;
            const float rstd1 = 1.0f / sqrtf(wave_sum(ps[q]) * (1.0f / DM) + EPS);
            float s = 0.f;
#pragma unroll
            for (int j = 0; j < 4; ++j) { const int c = 8 * lane + 512 * j; const f32x4 g0 = *(const f32x4*)(g_post + c), g1 = *(const f32x4*)(g_post + c + 4);
                const u32x4 xv = xw[q][j], yv = yw[q][j];
                const f32x4 x0 = {bflo(xv.x), bfhi(xv.x), bflo(xv.y), bfhi(xv.y)}, x1 = {bflo(xv.z), bfhi(xv.z), bflo(xv.w), bfhi(xv.w)};
                const f32x4 y0 = {bflo(yv.x), bfhi(yv.x), bflo(yv.y), bfhi(yv.y)}, y1 = {bflo(yv.z), bfhi(yv.z), bflo(yv.w), bfhi(yv.w)};
                const f32x4 a = x0 + y0 * rstd1 * g0, b = x1 + y1 * rstd1 * g1;
                s += (a.x * a.x + a.y * a.y) + (a.z * a.z + a.w * a.w) + (b.x * b.x + b.y * b.y) + (b.z * b.z + b.w * b.w);
                if (outf) { float* op = outf + (size_t)r * DM + c; *(f32x4*)op = a; *(f32x4*)(op + 4) = b; }
                else { u32x4 o; o.x = pk2h(a.x, a.y); o.y = pk2h(a.z, a.w); o.z = pk2h(b.x, b.y); o.w = pk2h(b.z, b.w); *(u32x4*)(xb + (size_t)r * DM + c) = o; }
                if (xb8) { u32x2 o8; o8.x = pk4_fp8(a.x, a.y, a.z, a.w); o8.y = pk4_fp8(b.x, b.y, b.z, b.w); *(u32x2*)(xb8 + (size_t)r * DM + c) = o8; } }
            s = wave_sum(s); if (lane == 0) ss[r] = s; }
    }
}
__device__ __forceinline__ void norm_phase(Frame& F, bf16* xb, const bf16* y, const float* part, const float* g_post, float* ss, float* outf, unsigned char* xb8 = nullptr) {
    norm_rows(0, MTOK, F.vcu * NWAVES + F.wave, F.G * NWAVES, xb, y, part, g_post, ss, outf, xb8);
}
__device__ __forceinline__ void panel_sync(unsigned* cnt, unsigned* tmo) {
    asm volatile("s_waitcnt vmcnt(0)" ::: "memory");
    __syncthreads();
    if (threadIdx.x == 0) {
        __builtin_amdgcn_fence(__ATOMIC_RELEASE, "agent"); asm volatile("s_waitcnt vmcnt(0)" ::: "memory");
        (void)__hip_atomic_fetch_add(cnt, 1u, __ATOMIC_RELAXED, __HIP_MEMORY_SCOPE_AGENT);
        unsigned sp = 0u;
        while (__hip_atomic_load(cnt, __ATOMIC_RELAXED, __HIP_MEMORY_SCOPE_AGENT) < 4u) { __builtin_amdgcn_s_sleep(1);
            if ((++sp & 255u) == 0u) { if (__hip_atomic_load(tmo, __ATOMIC_RELAXED, __HIP_MEMORY_SCOPE_AGENT)) break; if (sp > (1u << 18)) { atomicAdd(tmo, 1u); break; } } }
        __builtin_amdgcn_fence(__ATOMIC_ACQUIRE, "agent"); asm volatile("s_waitcnt vmcnt(0)" ::: "memory");
    }
    __syncthreads();
}
__device__ __forceinline__ void norm_phase_shadow(Frame& F, const bf16* xb, const bf16* y, const float* part, const float* g_post, float* ss, bf16* xdst) {
    int lane_ = threadIdx.x & 63; asm volatile("" : "+v"(lane_));
    const int gw = F.vcu * NWAVES + F.wave, NGW = F.G * NWAVES, lane = lane_;
    for (int r = gw; r < MTOK; r += NGW) {
        const float ps = lane < 32 ? part[(size_t)r * 32 + lane] : 0.f;
        const float rstd1 = 1.0f / sqrtf(wave_sum(ps) * (1.0f / DM) + EPS);
        float s = 0.f;
#pragma unroll
        for (int j = 0; j < 4; ++j) { const int c = 8 * lane + 512 * j;
            const u32x4 xw = *(const u32x4*)(xb + (size_t)r * DM + c), yw = *(const u32x4*)(y + (size_t)r * DM + c); const f32x4 g0 = *(const f32x4*)(g_post + c), g1 = *(const f32x4*)(g_post + c + 4);
            const f32x4 x0 = {bflo(xw.x), bfhi(xw.x), bflo(xw.y), bfhi(xw.y)}, x1 = {bflo(xw.z), bfhi(xw.z), bflo(xw.w), bfhi(xw.w)};
            const f32x4 y0 = {bflo(yw.x), bfhi(yw.x), bflo(yw.y), bfhi(yw.y)}, y1 = {bflo(yw.z), bfhi(yw.z), bflo(yw.w), bfhi(yw.w)};
            const f32x4 a = x0 + y0 * rstd1 * g0, b = x1 + y1 * rstd1 * g1;
            s += (a.x * a.x + a.y * a.y) + (a.z * a.z + a.w * a.w) + (b.x * b.x + b.y * b.y) + (b.z * b.z + b.w * b.w);
            u32x4 o; o.x = pk2h(a.x, a.y); o.y = pk2h(a.z, a.w); o.z = pk2h(b.x, b.y); o.w = pk2h(b.z, b.w); *(u32x4*)(xdst + (size_t)r * DM + c) = o; }
        s = wave_sum(s); if (lane == 0) ss[r] = s;
    }
}
__device__ __forceinline__ void xsoftmax_phase(Frame& F, const float* logit, bf16* prob, const float* ss) {
    int lane_ = threadIdx.x & 63; asm volatile("" : "+v"(lane_));
    const int gw = F.vcu * NWAVES + F.wave, NGW = F.G * NWAVES, lane = lane_;
    constexpr float C0 = 1.4426950408889634f * 0.04419417382415922f;
    for (int r = gw; r < MTOK; r += NGW) {
        const float C2 = C0 / sqrtf(ss[r] * (1.0f / DM) + EPS);
#pragma unroll
        for (int hd = 0; hd < 4; ++hd) { const f32x4 v = *(const f32x4*)(logit + (size_t)r * 1024 + hd * 256 + 4 * lane);
            const float mx = wave_max(fmaxf(fmaxf(v.x, v.y), fmaxf(v.z, v.w)));
            const float e0 = __builtin_amdgcn_exp2f((v.x - mx) * C2), e1 = __builtin_amdgcn_exp2f((v.y - mx) * C2), e2 = __builtin_amdgcn_exp2f((v.z - mx) * C2), e3 = __builtin_amdgcn_exp2f((v.w - mx) * C2);
            const float inv = 1.0f / wave_sum((e0 + e1) + (e2 + e3));
            u32x2 o; o.x = pk2h(e0 * inv, e1 * inv); o.y = pk2h(e2 * inv, e3 * inv);
            *(u32x2*)(prob + (size_t)r * 1024 + hd * 256 + 4 * lane) = o; }
    }
}
namespace dsa {
using pg8::i32x8; using pg8::i32x4;
constexpr int LDKV = LDP, LDO = 2 * MIXP, BL_OFF = 67584 + 512;
constexpr int D = 128; constexpr float THR = 6.f;
constexpr float SCALE = 0.08838834764831845f;
constexpr int NW = 8, QBLK = 32, KVBLK = 64, QB = NW * QBLK;
constexpr int SHM_V = KVBLK * D * 2, SHM_K = KVBLK * D * 2;
template <class A, class Bt> struct same_t { static constexpr bool v = false; };
template <class A> struct same_t<A, A> { static constexpr bool v = true; };

#define KSWZ(row, colB) ((row) * 256 + ((colB) ^ (((row) & 7) << 4)))
#define SBAR() __builtin_amdgcn_sched_barrier(0)
#define KSWZ8(row, colB) ((row) * 128 + ((colB) ^ (((row) & 7) << 4)))
__device__ __forceinline__ u32x2 bf8_to_e4m3(bf16x8 v) { const u32x4 w = *reinterpret_cast<const u32x4*>(&v);
    u32x2 o; o.x = pk4_fp8(bflo(w.x), bfhi(w.x), bflo(w.y), bfhi(w.y)); o.y = pk4_fp8(bflo(w.z), bfhi(w.z), bflo(w.w), bfhi(w.w)); return o; }
__device__ __forceinline__ int v_st(int k, int c) { const int kk = (k & ~0xC) | ((k & 4) << 1) | ((k & 8) >> 1); return ((kk >> 3) * 4 + (c >> 5)) * 512 + ((kk & 7) * 32 + (c & 31)) * 2; }
__device__ __forceinline__ int v_rd_base(int lane) { return ((lane & 3) << 3) | (((lane >> 2) & 3) << 6) | (((lane >> 4) & 1) << 5) | (((lane >> 5) & 1) << 8); }
constexpr int v_rd_off(int d0, int ks, int half) { return d0 * 512 + ks * 4096 + half * 2048; }
__device__ __forceinline__ int crow(int r, int hi) { return (r & 3) + 8 * (r >> 2) + 4 * hi; }
__device__ __forceinline__ unsigned cvtpk(float lo, float hi) {
    unsigned r; asm volatile("v_cvt_pk_bf16_f32 %0, %1, %2" : "=v"(r) : "v"(lo), "v"(hi)); return r;
}
__device__ __forceinline__ bf16x8 pack8(f32x4 a, f32x4 b) {
    u32x4 w = {cvtpk(a[0], a[1]), cvtpk(a[2], a[3]), cvtpk(b[0], b[1]), cvtpk(b[2], b[3])};
    return *reinterpret_cast<bf16x8*>(&w);
}
template <class T> __device__ __forceinline__ bf16x8 load8(const T* p) {
    if constexpr (same_t<T, float>::v) { return pack8(*(const f32x4*)p, *(const f32x4*)(p + 4)); }
    else { return *reinterpret_cast<const bf16x8*>(p); }
}
__device__ __forceinline__ void dsa_mask_tile(f32x16& p0, f32x16& p1, unsigned long long mw, int hi) {
    const unsigned lo = (unsigned)mw >> (4 * hi), hw = (unsigned)(mw >> 32) >> (4 * hi);
#pragma unroll
    for (int r = 0; r < 16; ++r) {
        const int c = (r & 3) + 8 * (r >> 2);
        const unsigned t0 = (unsigned)__builtin_amdgcn_sbfe((int)lo, c, 1), t1 = (unsigned)__builtin_amdgcn_sbfe((int)hw, c, 1);
        p0[r] = __uint_as_float((__float_as_uint(p0[r]) & t0) | (0xFF800000u & ~t0));
        p1[r] = __uint_as_float((__float_as_uint(p1[r]) & t1) | (0xFF800000u & ~t1));
    }
}
__device__ __forceinline__ void dsa_bias_tile(f32x16& p0, f32x16& p1, int dq, const float* BL) {
#pragma unroll
    for (int r = 0; r < 16; ++r) {
        const int c = (r & 3) + 8 * (r >> 2);
        int d0 = dq - c, d1 = dq - c - 32;
        d0 = d0 < 0 ? 0 : (d0 > 127 ? 127 : d0); d1 = d1 < 0 ? 0 : (d1 > 127 ? 127 : d1);
        p0[r] += BL[d0]; p1[r] += BL[d1];
    }
}
__device__ __forceinline__ void partialSM(f32x16& p0, f32x16& p1, float& m_reg, float& mn, float& alpha) {
    float pmax = p0[0]; for (int r = 1; r < 16; ++r) pmax = fmaxf(pmax, p0[r]); for (int r = 0; r < 16; ++r) pmax = fmaxf(pmax, p1[r]);
    { auto rr = __builtin_amdgcn_permlane32_swap(__float_as_uint(pmax), __float_as_uint(pmax), false, false);
      pmax = fmaxf(__uint_as_float(rr[0]), __uint_as_float(rr[1])); }
    constexpr float C2 = 1.4426950408889634f * SCALE;
    if (__builtin_expect(__all((pmax - m_reg) * SCALE <= THR), 1)) { mn = m_reg; alpha = 1.f; }
    else { mn = fmaxf(m_reg, pmax); alpha = __builtin_amdgcn_exp2f((m_reg - mn) * C2); m_reg = mn; }
    const float mnL = -mn * C2;
    for (int r = 0; r < 16; ++r) p0[r] = fmaf(p0[r], C2, mnL); for (int r = 0; r < 16; ++r) p1[r] = fmaf(p1[r], C2, mnL);
    for (int r = 0; r < 16; ++r) p0[r] = __builtin_amdgcn_exp2f(p0[r]);
}
__device__ __forceinline__ void finishSM(f32x16& p0, f32x16& p1, float alpha, float& l_reg, bf16x8& pa0, bf16x8& pa1, bf16x8& pa2, bf16x8& pa3) {
    for (int r = 0; r < 16; ++r) p1[r] = __builtin_amdgcn_exp2f(p1[r]);
    float ps = 0; for (int r = 0; r < 16; ++r) ps += p0[r]; for (int r = 0; r < 16; ++r) ps += p1[r];
    { auto rr = __builtin_amdgcn_permlane32_swap(__float_as_uint(ps), __float_as_uint(ps), false, false);
      ps = __uint_as_float(rr[0]) + __uint_as_float(rr[1]); }
    l_reg = l_reg * alpha + ps;
#define PK4(P, B_, OUT) do { unsigned a0 = cvtpk(P[B_+0], P[B_+1]), a1 = cvtpk(P[B_+2], P[B_+3]);                          \
        unsigned b0 = cvtpk(P[B_+4], P[B_+5]), b1 = cvtpk(P[B_+6], P[B_+7]);                                             \
        auto r0 = __builtin_amdgcn_permlane32_swap(a0, b0, false, false); auto r1 = __builtin_amdgcn_permlane32_swap(a1, b1, false, false); \
        u32x4 w = {r0[0], r1[0], r0[1], r1[1]}; OUT = *reinterpret_cast<bf16x8*>(&w); } while (0)
    PK4(p0, 0, pa0); PK4(p0, 8, pa1); PK4(p1, 0, pa2); PK4(p1, 8, pa3);
#undef PK4
}
template <int KB, bool SK>
__device__ __forceinline__ void qkt(f32x16& p0, f32x16& p1, const char* K_lds, int r32, int hi, const bf16x8* qr, bool act) {
    if (SK && !act) { const float NEG = -__builtin_inff();
#pragma unroll
        for (int r = 0; r < 16; ++r) { p0[r] = NEG; p1[r] = NEG; } return; }
    p0 = f32x16{}; p1 = f32x16{};
    const char* kb[4];
#pragma unroll
    for (int dd = 0; dd < 4; ++dd) kb[dd] = K_lds + KB * SHM_K + KSWZ(r32, (dd * 16 + hi * 8) * 2);
#pragma unroll
    for (int d0 = 0; d0 < 8; ++d0) { const char* a = kb[d0 & 3] + (d0 >> 2) * 128;
        bf16x8 b0 = *reinterpret_cast<const bf16x8*>(a);
        bf16x8 b1 = *reinterpret_cast<const bf16x8*>(a + 32 * 256);
        p0 = __builtin_amdgcn_mfma_f32_32x32x16_bf16(b0, qr[d0], p0, 0, 0, 0);
        p1 = __builtin_amdgcn_mfma_f32_32x32x16_bf16(b1, qr[d0], p1, 0, 0, 0); }
}
template <int KB, bool SK>
__device__ __forceinline__ void qkt8(f32x16& p0, f32x16& p1, const char* K_lds, int r32, int hi, const i32x8* q8, bool act) {
    if (SK && !act) { const float NEG = -__builtin_inff();
#pragma unroll
        for (int r = 0; r < 16; ++r) { p0[r] = NEG; p1[r] = NEG; } return; }
    const char* kb = K_lds + KB * SHM_K + r32 * 128; const int sw = r32 & 7;
#pragma unroll
    for (int m = 0; m < 2; ++m) {
        const char* c0 = kb + (((4 * m + 2 * hi) ^ sw) << 4); const char* c1 = kb + (((4 * m + 2 * hi + 1) ^ sw) << 4);
        const i32x4 a0 = *reinterpret_cast<const i32x4*>(c0), a1 = *reinterpret_cast<const i32x4*>(c1), b0 = *reinterpret_cast<const i32x4*>(c0 + 32 * 128), b1 = *reinterpret_cast<const i32x4*>(c1 + 32 * 128);
        const i32x8 ka = __builtin_shufflevector(a0, a1, 0, 1, 2, 3, 4, 5, 6, 7), kc = __builtin_shufflevector(b0, b1, 0, 1, 2, 3, 4, 5, 6, 7);
        if (m == 0) { asm volatile("v_mfma_f32_32x32x64_f8f6f4 %0, %1, %2, 0" : "=&v"(p0) : "v"(ka), "v"(q8[0])); asm volatile("v_mfma_f32_32x32x64_f8f6f4 %0, %1, %2, 0" : "=&v"(p1) : "v"(kc), "v"(q8[0])); }
        else { asm volatile("v_mfma_f32_32x32x64_f8f6f4 %0, %1, %2, %0" : "+v"(p0) : "v"(ka), "v"(q8[1])); asm volatile("v_mfma_f32_32x32x64_f8f6f4 %0, %1, %2, %0" : "+v"(p1) : "v"(kc), "v"(q8[1])); } }
    asm volatile("s_nop 15\n\ts_nop 3" : "+v"(p0), "+v"(p1));
}
template <int VB, bool SK>
__device__ __forceinline__ void pv_tile(f32x16* o, int vb0, bf16x8 pa0, bf16x8 pa1, bf16x8 pa2, bf16x8 pa3, bool act) {
    if (SK && !act) return;
#define TRRD(dst, off) asm volatile("ds_read_b64_tr_b16 %0, %1 offset:%2" : "=&v"(dst) : "v"(vb0), "i"(off) : "memory")
#define PV_D0(d0) do { s16x4 l0, l1, l2, l3, h0, h1, h2, h3; constexpr int b_ = VB * SHM_V + v_rd_off(d0, 0, 0);     \
        TRRD(l0, b_); TRRD(h0, b_ + 2048); TRRD(l1, b_ + 4096); TRRD(h1, b_ + 6144); TRRD(l2, b_ + 8192); TRRD(h2, b_ + 10240); TRRD(l3, b_ + 12288); TRRD(h3, b_ + 14336); \
        asm volatile("s_waitcnt lgkmcnt(0)" ::: "memory"); SBAR();                 \
        o[d0] = __builtin_amdgcn_mfma_f32_32x32x16_bf16(pa0, (bf16x8){l0[0], l0[1], l0[2], l0[3], h0[0], h0[1], h0[2], h0[3]}, o[d0], 0, 0, 0);   \
        o[d0] = __builtin_amdgcn_mfma_f32_32x32x16_bf16(pa1, (bf16x8){l1[0], l1[1], l1[2], l1[3], h1[0], h1[1], h1[2], h1[3]}, o[d0], 0, 0, 0);   \
        o[d0] = __builtin_amdgcn_mfma_f32_32x32x16_bf16(pa2, (bf16x8){l2[0], l2[1], l2[2], l2[3], h2[0], h2[1], h2[2], h2[3]}, o[d0], 0, 0, 0);   \
        o[d0] = __builtin_amdgcn_mfma_f32_32x32x16_bf16(pa3, (bf16x8){l3[0], l3[1], l3[2], l3[3], h3[0], h3[1], h3[2], h3[3]}, o[d0], 0, 0, 0); } while (0)
    PV_D0(0); PV_D0(1); PV_D0(2); PV_D0(3);
#undef PV_D0
#undef TRRD
}

__device__ __forceinline__ void finishSM8(f32x16& p0, f32x16& p1, float alpha, float& l_reg, i32x8& pa) {
    for (int r = 0; r < 16; ++r) p1[r] = __builtin_amdgcn_exp2f(p1[r]);
    float ps = 0; for (int r = 0; r < 16; ++r) ps += p0[r]; for (int r = 0; r < 16; ++r) ps += p1[r];
    { auto rr = __builtin_amdgcn_permlane32_swap(__float_as_uint(ps), __float_as_uint(ps), false, false);
      ps = __uint_as_float(rr[0]) + __uint_as_float(rr[1]); }
    l_reg = l_reg * alpha + ps;
#pragma unroll
    for (int d = 0; d < 4; ++d) { pa[d] = (int)pk4_fp8(p0[4 * d], p0[4 * d + 1], p0[4 * d + 2], p0[4 * d + 3]); pa[4 + d] = (int)pk4_fp8(p1[4 * d], p1[4 * d + 1], p1[4 * d + 2], p1[4 * d + 3]); }
}
__device__ __forceinline__ int vt8_off(int d, int chunk) { return d * 64 + ((chunk ^ (((d >> 2) & 1) << 1)) << 4); }
template <int VB, bool SK>
__device__ __forceinline__ void pv_tile8(f32x16* o, const char* vrd, i32x8 pa, bool act) {
    if (SK && !act) return;
#pragma unroll
    for (int d0 = 0; d0 < 4; ++d0) { const char* vp = vrd + VB * SHM_V + d0 * 2048;
        const i32x4 lo_ = *reinterpret_cast<const i32x4*>(vp), hi_ = *reinterpret_cast<const i32x4*>(vp + 16);
        const i32x8 vb = __builtin_shufflevector(lo_, hi_, 0, 1, 2, 3, 4, 5, 6, 7);
        asm volatile("v_mfma_f32_32x32x64_f8f6f4 %0, %1, %2, %0" : "+v"(o[d0]) : "v"(pa), "v"(vb)); }
    asm volatile("s_nop 15\n\ts_nop 3" : "+v"(o[0]), "+v"(o[1]), "+v"(o[2]), "+v"(o[3]));
}

template <class TIn, class TOut> struct BlockRef { const TIn* Q; const TIn* K; const TIn* V; TOut* O; const unsigned long long* MK; int P0; const unsigned char* K8; const unsigned char* V8; };
template <class TIn> struct Seam {
    bf16x8 qr[8];
    i32x8 q8[2];
    bf16x8 st_v0, st_v1, st_k0, st_k1; u32x2 sk0, sk1; u32x4 sv; f32x4 sf0, sf1, sf2, sf3;
    f32x4 tq[16];
};
#define ROW(p, k0, rr) ((p) + (size_t)((k0) + (rr)) * LDKV + sc)
#define VMW() asm volatile("s_waitcnt vmcnt(0)" ::: "memory")
#define VMWN(n) asm volatile("s_waitcnt vmcnt(%0)" :: "i"(n) : "memory")
#define SLOAD_H(Kp, Vp, k0) do { S.sv = *(const u32x4*)((Vp) + (size_t)vd * 4096 + (k0) + 16 * vkc);                 \
                         S.sk0 = *(const u32x2*)((Kp) + (size_t)((k0) + sr) * 1024 + sc); S.sk1 = *(const u32x2*)((Kp) + (size_t)((k0) + 32 + sr) * 1024 + sc); } while (0)
#define SWRITE_HK(bf) do { *(u32x2*)(K_lds + (bf) * SHM_K + kws) = S.sk0; *(u32x2*)(K_lds + (bf) * SHM_K + kws + 32 * 128) = S.sk1; } while (0)
#define SWRITE_HV(bf) do { *(u32x2*)(V_lds + (bf) * SHM_V + vwr0) = (u32x2){S.sv.x, S.sv.z}; *(u32x2*)(V_lds + (bf) * SHM_V + vwr1) = (u32x2){S.sv.y, S.sv.w}; } while (0)
#define SWRITE_H(bf) do { SWRITE_HV(bf); SWRITE_HK(bf); } while (0)
#define SLOAD_F(p, k0) do { S.sf0 = *(const f32x4*)ROW(p, k0, sr); S.sf1 = *(const f32x4*)(ROW(p, k0, sr) + 4);                \
                            S.sf2 = *(const f32x4*)ROW(p, k0, 32 + sr); S.sf3 = *(const f32x4*)(ROW(p, k0, 32 + sr) + 4); } while (0)
#define SWRITE_KF(bf) do { *(bf16x8*)(K_lds + (bf) * SHM_K + kws) = pack8(S.sf0, S.sf1); *(bf16x8*)(K_lds + (bf) * SHM_K + kws + 32 * 256) = pack8(S.sf2, S.sf3); } while (0)
#define SWRITE_VF(bf) do { *(bf16x8*)(V_lds + (bf) * SHM_V + vst0) = pack8(S.sf0, S.sf1); *(bf16x8*)(V_lds + (bf) * SHM_V + vst1) = pack8(S.sf2, S.sf3); } while (0)
template <class TIn, class TOut>
__device__ __forceinline__ void causal_swa_prime(const BlockRef<TIn, TOut>& cur, char* lds, Seam<TIn>& S) {
    constexpr bool F32 = same_t<TIn, float>::v;
    int tid_ = threadIdx.x; asm volatile("" : "+v"(tid_));
    const int tid = tid_, wid = __builtin_amdgcn_readfirstlane(tid >> 6), lane = tid & 63, r32 = lane & 31, hi = lane >> 5;
    const int sr = tid >> 4, sc = (tid & 15) * 8, kws = KSWZ8(sr, sc), vd = tid >> 2, vkc = tid & 3; char* K_lds = lds + 2 * SHM_V;
    const int kb0 = 0;
    for (int d0 = 0; d0 < 8; ++d0) S.qr[d0] = load8<TIn>(cur.Q + (size_t)(wid * QBLK + r32) * LDKV + (d0 >> 2) * 64 + hi * 32 + (d0 & 3) * 8);
    if constexpr (F32) { SLOAD_F((const float*)cur.K, kb0); VMW(); SWRITE_KF(0); SBAR(); SLOAD_F((const float*)cur.V, kb0); }
    else { SLOAD_H(cur.K8, cur.V8, kb0); VMW(); SWRITE_HK(0); }
    __syncthreads();
}
template <class TIn, class TOut>
__device__ __forceinline__ void causal_swa_block(const BlockRef<TIn, TOut>& cur, const BlockRef<TIn, TOut>& nxt, int skv, char* lds, Seam<TIn>& S) {
    constexpr bool F32 = same_t<TIn, float>::v;
    int tid_ = threadIdx.x; asm volatile("" : "+v"(tid_));
    const int tid = tid_, wid = __builtin_amdgcn_readfirstlane(tid >> 6), lane = tid & 63, r32 = lane & 31, hi = lane >> 5;
    const int j_lo = 0;
    int j_hi = (cur.P0 + QB - 1) / KVBLK + 1; if (j_hi > skv / KVBLK) j_hi = skv / KVBLK;
    const int NT = j_hi - j_lo;
    const int kbn = 0;
    const int qlo = cur.P0 + wid * QBLK, qm = qlo + r32 - 4 * hi;
    const unsigned long long* MK = cur.MK + (size_t)(wid * QBLK + r32) * 64; const float* BLp = (const float*)(lds + BL_OFF);
    unsigned long long mwA = MK[0], mwB = MK[1], mwN = 0ull;
    char* V_lds = lds; char* K_lds = lds + 2 * SHM_V;
    float* ws = (float*)(lds + 2 * SHM_V + 2 * SHM_K) + wid * 64; float* li_l = ws, * al_l = ws + 32;
    float m_reg = -1e30f, l_reg = 0; f32x16 o[4] = {};
    const int sr = tid >> 4, sc = (tid & 15) * 8, kws = KSWZ8(sr, sc);
    const int vd = tid >> 2, vkc = tid & 3, vwr0 = vt8_off(vd, vkc >> 1) + 8 * (vkc & 1), vwr1 = vt8_off(vd, 2 + (vkc >> 1)) + 8 * (vkc & 1);
    constexpr int vst0 = 0, vst1 = 0;
    const char* vrd = V_lds + vt8_off(r32, 2 * hi);
    const TIn* Kh = cur.K; const unsigned char* Vh = cur.V8; const unsigned char* Kh8 = cur.K8; (void)Kh;
#define RESC(a) do { if (__any((a) < 1.f)) { if (hi == 0) al_l[r32] = (a); asm volatile("s_waitcnt lgkmcnt(0)" ::: "memory");              \
                     for (int d_ = 0; d_ < 4; ++d_) for (int r = 0; r < 16; ++r) o[d_][r] *= al_l[crow(r, hi)]; } } while (0)
#define KBASE(t) ((j_lo + (t)) * KVBLK)
#define ACT(t) (KBASE(t) <= qlo + QBLK - 1)
#define MASKT(P0_, P1_, t, MW_) do { const int kb_ = KBASE(t); if (kb_ + 176 > qlo) dsa_bias_tile(P0_, P1_, qm - kb_, BLp); dsa_mask_tile(P0_, P1_, MW_, hi); } while (0)
    constexpr int NQL = F32 ? 16 : 8;
    constexpr bool SK = true;
#define SEAM_K0() do { VMWN(NQL); if constexpr (F32) { SWRITE_KF(0); SBAR(); SLOAD_F((const float*)nxt.V, kbn); } else { SWRITE_HK(0); } SBAR(); } while (0)
    f32x16 pA0, pA1, pB0, pB1; float mnA, mnB, alA, alB; i32x8 pa8;
    if constexpr (F32) { VMW(); SWRITE_VF(0); SBAR(); } else { SWRITE_HV(0); SBAR(); }
    if (NT > 1) { if constexpr (F32) SLOAD_F((const float*)Kh, KBASE(1)); else SLOAD_H(Kh8, Vh, KBASE(1)); }
    if constexpr (!F32) {
#pragma unroll
        for (int m = 0; m < 2; ++m)
#pragma unroll
            for (int d = 0; d < 8; d += 2) { const u32x2 o = bf8_to_e4m3(S.qr[4 * m + (d >> 1)]); S.q8[m][d] = (int)o.x; S.q8[m][d + 1] = (int)o.y; } }
    SBAR(); qkt8<0, SK>(pA0, pA1, K_lds, r32, hi, S.q8, ACT(0));
    if constexpr (F32) { if (NT > 1) { VMW(); SWRITE_KF(1); SBAR(); SLOAD_F((const float*)Vh, KBASE(1)); } }
    MASKT(pA0, pA1, 0, mwA); if (NT > 2) mwA = MK[2]; partialSM(pA0, pA1, m_reg, mnA, alA);
    if (NT > 1) { VMW(); if constexpr (F32) { SWRITE_VF(1); SBAR(); if (NT > 2) SLOAD_F((const float*)Kh, KBASE(2)); } else SWRITE_H(1); }
    __syncthreads();
#define HALF_STEP(PX0, PX1, mnX, alX, PY0, PY1, alY, t, KB, VB, SB, MWX) do {                                                      \
        SBAR(); qkt8<KB, SK>(PX0, PX1, K_lds, r32, hi, S.q8, ACT(t));                                           \
        finishSM8(PY0, PY1, alY, l_reg, pa8); SBAR();                                                         \
        if ((t) + 1 < NT) { if constexpr (F32) { VMW(); SWRITE_KF(SB); SBAR(); SLOAD_F((const float*)Vh, KBASE((t) + 1)); }  \
                            else { SLOAD_H(Kh8, Vh, KBASE((t) + 1)); } if ((t) + 2 < NT) mwN = MK[(t) + 2]; SBAR(); }                                               \
        pv_tile8<VB, SK>(o, vrd, pa8, ACT((t) - 1)); MASKT(PX0, PX1, (t), MWX); partialSM(PX0, PX1, m_reg, mnX, alX);                                        \
        __syncthreads();                                                                                                      \
        if ((t) + 1 < NT) { VMW(); if constexpr (F32) { SWRITE_VF(SB); SBAR(); if ((t) + 2 < NT) SLOAD_F((const float*)Kh, KBASE((t) + 2)); } \
                            else { SWRITE_H(SB); } }                                                                          \
        MWX = mwN;     \
        RESC(alX); __syncthreads(); } while (0)
    for (int t = 1; t + 1 < NT; t += 2) {
        HALF_STEP(pB0, pB1, mnB, alB, pA0, pA1, alA, t, 1, 0, 0, mwB);
        HALF_STEP(pA0, pA1, mnA, alA, pB0, pB1, alB, t + 1, 0, 1, 1, mwA);
    }
    const bool even = (NT & 1) == 0;
    if (even) { SBAR(); qkt8<1, SK>(pB0, pB1, K_lds, r32, hi, S.q8, ACT(NT - 1)); SBAR(); }
#define QROW(e) (nxt.Q + (size_t)(wid * QBLK + r32) * LDKV + ((e) >> 1) * 16 + hi * 8 + ((e) & 1) * 4)
    if constexpr (F32) { SLOAD_F((const float*)nxt.K, kbn); SBAR();
#pragma unroll
        for (int e = 0; e < 8; ++e) S.tq[e] = *(const f32x4*)QROW(e); }
    else { SLOAD_H(nxt.K8, nxt.V8, kbn); SBAR();
#pragma unroll
        for (int d0 = 0; d0 < 8; ++d0) S.qr[d0] = load8<TIn>(nxt.Q + (size_t)(wid * QBLK + r32) * LDKV + (d0 >> 2) * 64 + hi * 32 + (d0 & 3) * 8); }
    SBAR();
    finishSM8(pA0, pA1, alA, l_reg, pa8); SBAR();
    if constexpr (F32) {
#pragma unroll
        for (int e = 8; e < 16; ++e) S.tq[e] = *(const f32x4*)QROW(e); SBAR(); }
#undef QROW
    pv_tile8<0, SK>(o, vrd, pa8, ACT(even ? NT - 2 : NT - 1));
    if (even) { MASKT(pB0, pB1, NT - 1, mwB); partialSM(pB0, pB1, m_reg, mnB, alB); __syncthreads(); RESC(alB);
        finishSM8(pB0, pB1, alB, l_reg, pa8); SBAR(); pv_tile8<1, SK>(o, vrd, pa8, ACT(NT - 1)); }
    SBAR(); SEAM_K0();
    if (hi == 0) li_l[r32] = l_reg; asm volatile("s_waitcnt lgkmcnt(0)" ::: "memory");
    float rli[16];
#pragma unroll
    for (int r = 0; r < 16; ++r) rli[r] = __builtin_amdgcn_rcpf(li_l[crow(r, hi)]);
    TOut* Ow = cur.O + (size_t)(wid * QBLK) * LDO;
#pragma unroll
    for (int r = 0; r < 16; ++r) { const int orow = crow(r, hi);
#pragma unroll
        for (int d0 = 0; d0 < 4; ++d0) { const float v = o[d0][r] * rli[r];
            if constexpr (same_t<TOut, float>::v) { Ow[(size_t)orow * LDO + d0 * 32 + r32] = v; }
            else if constexpr (same_t<TOut, unsigned char>::v) { Ow[(size_t)orow * LDO + d0 * 32 + r32] = (unsigned char)(__builtin_amdgcn_cvt_pk_fp8_f32(v * FP8_ODSA_SCALE, 0.0f, 0u, false) & 0xffu); }
            else { const float vn = __shfl_xor(v, 1);
                   if ((r32 & 1) == 0) *(unsigned*)(Ow + (size_t)orow * LDO + d0 * 32 + r32) = cvtpk(v, vn); } } }
    if constexpr (F32) {
#pragma unroll
        for (int d0 = 0; d0 < 8; ++d0) S.qr[d0] = pack8(S.tq[2 * d0], S.tq[2 * d0 + 1]); }
    __syncthreads();
#undef RESC
#undef KBASE
#undef ACT
#undef MASKT
#undef SEAM_K0
#undef HALF_STEP
}
#undef ROW
#undef VMW
#undef VMWN
#undef SLOAD_H
#undef SWRITE_HK
#undef SWRITE_HV
#undef SWRITE_H
#undef SLOAD_F
#undef SWRITE_KF
#undef SWRITE_VF

}
#define MFMA16(a, b, c) __builtin_amdgcn_mfma_f32_16x16x32_bf16((a), (b), (c), 0, 0, 0)
#define MFMA32(a, b, c) __builtin_amdgcn_mfma_f32_32x32x16_bf16((a), (b), (c), 0, 0, 0)

constexpr int GL_Z = 0, GL_GT = 4096, GL_RS = 6144, GL_KST = 8192, GL_QD = 8192, GL_KI = 25600, GL_AM = 43008, GL_VS = 53248;
struct GlaArgs { const bf16* proj; const float* w2; const float* bg; const float* ghead; bf16* state; float* dec; float* bcum; bf16* mixcat; };

__device__ __forceinline__ unsigned gla_off_b(unsigned row, unsigned ch) { return 256u * row + 16u * (ch ^ (((row & 3u) << 2) | ((row >> 2) & 3u))); }
__device__ __forceinline__ unsigned gla_tr_addr(unsigned lane, unsigned cc, unsigned t) {
    const unsigned g = lane >> 4, q = (lane & 15u) >> 2, p = lane & 3u;
    return gla_off_b(8u * g + 4u * t + q, 2u * cc + (p >> 1)) + 8u * (p & 1u);
}
#define GLA_TRRD(dst, addr) asm volatile("ds_read_b64_tr_b16 %0, %1" : "=&v"(dst) : "v"(addr) : "memory")
__device__ __forceinline__ bf16x8 gla_vfrag(unsigned vs, unsigned lane, int ks, int vt) {
    const unsigned base = vs + (unsigned)((ks * 2 + (vt >> 3)) * 8192);
    s16x4 lo, hi; const unsigned a0 = base + gla_tr_addr(lane, (unsigned)(vt & 7), 0u), a1 = base + gla_tr_addr(lane, (unsigned)(vt & 7), 1u);
    asm volatile("ds_read_b64_tr_b16 %0, %2\n\tds_read_b64_tr_b16 %1, %3\n\ts_waitcnt lgkmcnt(0)" : "=&v"(lo), "=&v"(hi) : "v"(a0), "v"(a1) : "memory");
    return (bf16x8){lo[0], lo[1], lo[2], lo[3], hi[0], hi[1], hi[2], hi[3]};
}
__device__ __forceinline__ void gla_vfrag2(unsigned vs, unsigned lane, int vt, bf16x8& f0, bf16x8& f1) {
    const unsigned b0 = vs + (unsigned)((vt >> 3) * 8192), b1 = b0 + 16384u, o0 = gla_tr_addr(lane, (unsigned)(vt & 7), 0u), o1 = gla_tr_addr(lane, (unsigned)(vt & 7), 1u);
    s16x4 l0, h0, l1, h1; const unsigned a0 = b0 + o0, a1 = b0 + o1, a2 = b1 + o0, a3 = b1 + o1;
    asm volatile("ds_read_b64_tr_b16 %0, %4\n\tds_read_b64_tr_b16 %1, %5\n\tds_read_b64_tr_b16 %2, %6\n\tds_read_b64_tr_b16 %3, %7\n\ts_waitcnt lgkmcnt(0)"
                 : "=&v"(l0), "=&v"(h0), "=&v"(l1), "=&v"(h1) : "v"(a0), "v"(a1), "v"(a2), "v"(a3) : "memory");
    f0 = (bf16x8){l0[0], l0[1], l0[2], l0[3], h0[0], h0[1], h0[2], h0[3]}; f1 = (bf16x8){l1[0], l1[1], l1[2], l1[3], h1[0], h1[1], h1[2], h1[3]};
}
__device__ __forceinline__ void gla_a_unit(Frame& F, const GlaArgs& a, int b, int n, int h) {
    int tid = threadIdx.x; asm volatile("" : "+v"(tid));
    const int lane = tid & 63, wave = F.wave, fr = lane & 15, fq = lane >> 4, d = tid & 127, cg = tid >> 7;
    LAS float* Z = (LAS float*)(F.lds + GL_Z); LAS float* GT = (LAS float*)(F.lds + GL_GT); LAS bf16* KST = (LAS bf16*)(F.lds + GL_KST);
    const unsigned vs = (unsigned)(uintptr_t)(F.lds + GL_VS);
    const int tok0 = b * SEQ + n * 64, bh = b * 4 + h;
    const bf16* P = a.proj + (size_t)tok0 * LDP;
    u32x4 zw = {0u, 0u, 0u, 0u}; if (tid < 128) zw = *(const u32x4*)(P + (size_t)(tid >> 1) * LDP + C_GZ + (tid & 1) * 8);
    u32x4 vw[4];
#pragma unroll
    for (int i = 0; i < 4; ++i) { const int id = tid + 512 * i; vw[i] = *(const u32x4*)(P + (size_t)(id >> 5) * LDP + C_GV + h * 256 + (id & 31) * 8); }
    float w2[16];
#pragma unroll
    for (int r = 0; r < 16; ++r) w2[r] = a.w2[r * 512 + h * 128 + d];
    const float bias = a.bg[h * 128 + d];
    unsigned short kraw[16];
#pragma unroll
    for (int cc = 0; cc < 16; ++cc) kraw[cc] = P[(size_t)(cg * 16 + cc) * LDP + C_GK + h * 128 + d];
    if (tid < 128) { LAS float* z = Z + (tid >> 1) * 16 + (tid & 1) * 8;
        z[0] = bflo(zw.x); z[1] = bfhi(zw.x); z[2] = bflo(zw.y); z[3] = bfhi(zw.y); z[4] = bflo(zw.z); z[5] = bfhi(zw.z); z[6] = bflo(zw.w); z[7] = bfhi(zw.w); }
#pragma unroll
    for (int i = 0; i < 4; ++i) { const int id = tid + 512 * i, c = id >> 5, ch32 = id & 31;
        *(LAS u32x4*)(F.lds + GL_VS + ((c >> 5) * 2 + (ch32 >> 4)) * 8192 + gla_off_b((unsigned)(c & 31), (unsigned)(ch32 & 15))) = vw[i]; }
    __syncthreads();
    float bc[16]; float run = 0.f;
#pragma unroll
    for (int cc = 0; cc < 16; ++cc) { const int c = cg * 16 + cc; float acc = bias;
#pragma unroll
        for (int r4 = 0; r4 < 4; ++r4) { const f32x4 z = *(LAS f32x4*)(Z + c * 16 + r4 * 4); acc += z.x * w2[r4 * 4] + z.y * w2[r4 * 4 + 1] + z.z * w2[r4 * 4 + 2] + z.w * w2[r4 * 4 + 3]; }
        const float ls = fminf(acc, 0.f) - __logf(1.0f + __expf(-fabsf(acc)));
        run += ls * (1.0f / 16.0f); bc[cc] = run; }
    GT[cg * 128 + d] = run;
    __syncthreads();
    float off = 0.f, blast = 0.f;
#pragma unroll
    for (int g = 0; g < 4; ++g) { const float t = GT[g * 128 + d]; if (g < cg) off += t; blast += t; }
    float* BC = a.bcum + ((size_t)(bh * 64 + n) * 64 + cg * 16) * 128 + d;
    unsigned pk[8];
#pragma unroll
    for (int cc = 0; cc < 16; cc += 2) { const float b0 = bc[cc] + off, b1 = bc[cc + 1] + off;
        BC[cc * 128] = b0; BC[(cc + 1) * 128] = b1;
        pk[cc >> 1] = pk2(bf2f(kraw[cc]) * __expf(blast - b0), bf2f(kraw[cc + 1]) * __expf(blast - b1)); }
    *(LAS u32x4*)(KST + d * 72 + cg * 16) = (u32x4){pk[0], pk[1], pk[2], pk[3]};
    *(LAS u32x4*)(KST + d * 72 + cg * 16 + 8) = (u32x4){pk[4], pk[5], pk[6], pk[7]};
    if (cg == 0) a.dec[(size_t)(bh * 64 + n) * 128 + d] = __expf(blast);
    __syncthreads();
    bf16x8 af[2];
#pragma unroll
    for (int s = 0; s < 2; ++s) af[s] = *(LAS bf16x8*)(KST + (wave * 16 + fr) * 72 + s * 32 + fq * 8);
    bf16* ST = a.state + (size_t)(bh * 64 + n) * 32768;
#pragma unroll 4
    for (int vt = 0; vt < 16; ++vt) {
        bf16x8 b0, b1; gla_vfrag2(vs, (unsigned)lane, vt, b0, b1);
        f32x4 acc = {0.f, 0.f, 0.f, 0.f};
        acc = MFMA16(af[0], b0, acc); acc = MFMA16(af[1], b1, acc);
        u32x2 o; o.x = pk2(acc[0], acc[1]); o.y = pk2(acc[2], acc[3]);
        *(u32x2*)(ST + (size_t)(vt * 16 + fr) * 128 + wave * 16 + fq * 4) = o; }
    __syncthreads();
}
__device__ __forceinline__ void gla_scan(Frame& F, bf16* state, const float* dec) {
    int tid = threadIdx.x; asm volatile("" : "+v"(tid));
    for (int g = F.vcu * NTHR + tid; g < 16 * 8192; g += F.G * NTHR) {
        const int bh = g >> 13, e = (g & 8191) * 4, d = e & 127;
        bf16* p = state + (size_t)bh * 64 * 32768 + e; const float* dp = dec + (size_t)bh * 64 * 128 + d;
        f32x4 S = {0.f, 0.f, 0.f, 0.f};
#pragma unroll 8
        for (int n = 0; n < 64; ++n) { const u32x2 w = *(const u32x2*)(p + (size_t)n * 32768); const f32x4 dc = *(const f32x4*)(dp + n * 128);
            u32x2 o; o.x = pk2(S.x, S.y); o.y = pk2(S.z, S.w); *(u32x2*)(p + (size_t)n * 32768) = o;
            S.x = dc.x * S.x + bflo(w.x); S.y = dc.y * S.y + bfhi(w.x); S.z = dc.z * S.z + bflo(w.y); S.w = dc.w * S.w + bfhi(w.y); }
    }
}
__device__ __forceinline__ void gla_c_unit(Frame& F, const GlaArgs& a, int b, int n, int h) {
    int tid = threadIdx.x; asm volatile("" : "+v"(tid));
    const int lane = tid & 63, wave = F.wave, fr = lane & 15, fq = lane >> 4, d = tid & 127, cg = tid >> 7;
    LAS bf16* QD = (LAS bf16*)(F.lds + GL_QD); LAS bf16* KI = (LAS bf16*)(F.lds + GL_KI); LAS bf16* AM = (LAS bf16*)(F.lds + GL_AM); LAS float* RS = (LAS float*)(F.lds + GL_RS);
    const unsigned vs = (unsigned)(uintptr_t)(F.lds + GL_VS);
    const int tok0 = b * SEQ + n * 64, bh = b * 4 + h;
    const bf16* P = a.proj + (size_t)tok0 * LDP;
    u32x4 vw[4];
#pragma unroll
    for (int i = 0; i < 4; ++i) { const int id = tid + 512 * i; vw[i] = *(const u32x4*)(P + (size_t)(id >> 5) * LDP + C_GV + h * 256 + (id & 31) * 8); }
    const float* BC = a.bcum + ((size_t)(bh * 64 + n) * 64 + cg * 16) * 128 + d;
    float bc[16]; unsigned short qraw[16], kraw[16];
#pragma unroll
    for (int cc = 0; cc < 16; ++cc) { bc[cc] = BC[cc * 128]; qraw[cc] = P[(size_t)(cg * 16 + cc) * LDP + C_GQ + h * 128 + d]; kraw[cc] = P[(size_t)(cg * 16 + cc) * LDP + C_GK + h * 128 + d]; }
#pragma unroll
    for (int i = 0; i < 4; ++i) { const int id = tid + 512 * i, c = id >> 5, ch32 = id & 31;
        *(LAS u32x4*)(F.lds + GL_VS + ((c >> 5) * 2 + (ch32 >> 4)) * 8192 + gla_off_b((unsigned)(c & 31), (unsigned)(ch32 & 15))) = vw[i]; }
#pragma unroll
    for (int cc = 0; cc < 16; ++cc) { const int c = cg * 16 + cc; const float e = __expf(bc[cc]);
        QD[c * 136 + d] = (bf16)f2bf(bf2f(qraw[cc]) * 0.08838834764831845f * e);
        KI[c * 136 + d] = (bf16)f2bf(bf2f(kraw[cc]) * __expf(-bc[cc])); }
    __syncthreads();
    const int it = wave & 3, vh = wave >> 2, i = it * 16 + fr;
    const bf16* ST = a.state + (size_t)(bh * 64 + n) * 32768;
    bf16x8 sa[8][4]; u32x2 rw[8];
#pragma unroll
    for (int vt = 0; vt < 8; ++vt) { const int v0 = (vh * 8 + vt) * 16;
#pragma unroll
        for (int s = 0; s < 4; ++s) sa[vt][s] = *(const bf16x8*)(ST + (size_t)(v0 + fr) * 128 + s * 32 + fq * 8);
        rw[vt] = *(const u32x2*)(P + (size_t)i * LDP + C_GR + h * 256 + v0 + fq * 4); }
#pragma unroll
    for (int tt = 0; tt < 2; ++tt) { const int tile = wave * 2 + tt, ita = tile >> 2, jt = tile & 3;
        f32x4 acc = {0.f, 0.f, 0.f, 0.f};
        if (jt <= ita) {
#pragma unroll
            for (int s = 0; s < 4; ++s) { const bf16x8 ka = *(LAS bf16x8*)(KI + (jt * 16 + fr) * 136 + s * 32 + fq * 8), qb = *(LAS bf16x8*)(QD + (ita * 16 + fr) * 136 + s * 32 + fq * 8);
                acc = MFMA16(ka, qb, acc); } }
        const int ia = ita * 16 + fr, j0 = jt * 16 + fq * 4;
#pragma unroll
        for (int r = 0; r < 4; ++r) if (j0 + r > ia) acc[r] = 0.f;
        u32x2 o; o.x = pk2(acc[0], acc[1]); o.y = pk2(acc[2], acc[3]);
        *(LAS u32x2*)(AM + ia * 72 + j0) = o; }
    __syncthreads();
    bf16x8 bam[2], bqd[4];
#pragma unroll
    for (int s = 0; s < 2; ++s) bam[s] = *(LAS bf16x8*)(AM + i * 72 + s * 32 + fq * 8);
#pragma unroll
    for (int s = 0; s < 4; ++s) bqd[s] = *(LAS bf16x8*)(QD + i * 136 + s * 32 + fq * 8);
    f32x4 acc[8]; float ss = 0.f;
#pragma unroll
    for (int vt = 0; vt < 8; ++vt) {
        f32x4 c = {0.f, 0.f, 0.f, 0.f};
        { bf16x8 va0, va1; gla_vfrag2(vs, (unsigned)lane, vh * 8 + vt, va0, va1); c = MFMA16(va0, bam[0], c); c = MFMA16(va1, bam[1], c); }
#pragma unroll
        for (int s = 0; s < 4; ++s) c = MFMA16(sa[vt][s], bqd[s], c);
        acc[vt] = c; ss += (c[0] * c[0] + c[1] * c[1]) + (c[2] * c[2] + c[3] * c[3]); }
    ss += __shfl_xor(ss, 16); ss += __shfl_xor(ss, 32);
    if (fq == 0) RS[i * 2 + vh] = ss;
    __syncthreads();
    const float rstd = 1.0f / sqrtf((RS[i * 2] + RS[i * 2 + 1]) * (1.0f / 256.0f) + EPS);
#pragma unroll
    for (int vt = 0; vt < 8; ++vt) { const int v = (vh * 8 + vt) * 16 + fq * 4;
        const f32x4 gh = *(const f32x4*)(a.ghead + v);
        const float r0 = bflo(rw[vt].x), r1 = bfhi(rw[vt].x), r2 = bflo(rw[vt].y), r3 = bfhi(rw[vt].y);
        const float o0 = acc[vt][0] * rstd * gh.x * r0 / (1.0f + __expf(-r0)), o1 = acc[vt][1] * rstd * gh.y * r1 / (1.0f + __expf(-r1));
        const float o2 = acc[vt][2] * rstd * gh.z * r2 / (1.0f + __expf(-r2)), o3 = acc[vt][3] * rstd * gh.w * r3 / (1.0f + __expf(-r3));
        u32x2 o; o.x = pk2(o0, o1); o.y = pk2(o2, o3);
        *(u32x2*)(a.mixcat + (size_t)(tok0 + i) * MIXP + h * 256 + v) = o; }
    __syncthreads();
}

constexpr int IX_QI = 0, IX_PITCH = 1096, IX_WL = 70144, IX_H = 73728, IX_CL = 90112;
struct IdxArgs { const bf16* proj; const bf16* ikc; float* scr; unsigned long long* mask; };
__device__ __forceinline__ void idx_unit(Frame& F, const IdxArgs& a, int b, int q0) {
    int tid = threadIdx.x; asm volatile("" : "+v"(tid));
    const int lane = tid & 63, wave = F.wave, r32 = lane & 31, hi = lane >> 5;
    LAS bf16* QI = (LAS bf16*)(F.lds + IX_QI); LAS float* WL = (LAS float*)(F.lds + IX_WL);
    const size_t tokq = (size_t)b * SEQ + q0; const bf16* PQ = a.proj + tokq * LDP;
#pragma unroll
    for (int i = 0; i < 8; ++i) { const int id = tid + 512 * i, r = id >> 7, ch = id & 127;
        *(LAS u32x4*)(QI + r * IX_PITCH + ch * 8) = *(const u32x4*)(PQ + (size_t)r * LDP + C_IQ + ch * 8); }
    { const int r = tid >> 4, hh = tid & 15; WL[r * 16 + hh] = bf2f(PQ[(size_t)r * LDP + C_IW + hh]) * (0.03125f * 0.5f); }
    __syncthreads();
    { const int t = tid >> 4, d4 = (tid & 15) * 4; float q0 = 0.f, q1 = 0.f, q2 = 0.f, q3 = 0.f;
#pragma unroll
        for (int hh = 0; hh < 16; ++hh) { const float w = WL[t * 16 + hh]; const u32x2 qw = *(LAS u32x2*)(QI + t * IX_PITCH + hh * 64 + d4);
            q0 += w * bflo(qw.x); q1 += w * bfhi(qw.x); q2 += w * bflo(qw.y); q3 += w * bfhi(qw.y); }
        u32x2 o; o.x = pk2(q0, q1); o.y = pk2(q2, q3); *(LAS u32x2*)(QI + t * IX_PITCH + 1024 + d4) = o; }
    __syncthreads();
    float* scr = a.scr + (size_t)blockIdx.x * 32 * 4096;
    const int nk = q0 + 32, ng = (nk + 63) >> 6;
    const bf16* PK = a.ikc + (size_t)b * SEQ * 64;
#ifndef REP_SCORE
#define REP_SCORE 1
#endif
#ifndef REP_SEL
#define REP_SEL 1
#endif
    const int fr = lane & 15, fq = lane >> 4;
#define SC_QLOAD(QB, slot_) do { _Pragma("unroll") for (int qt = 0; qt < 2; ++qt) _Pragma("unroll") for (int s = 0; s < 2; ++s) \
        QB[qt][s] = *(LAS bf16x8*)(QI + (qt * 16 + fr) * IX_PITCH + (slot_) * 64 + s * 32 + fq * 8); } while (0)
#define SC_MMA(ACC, QB) do { _Pragma("unroll") for (int kt = 0; kt < 4; ++kt) _Pragma("unroll") for (int qt = 0; qt < 2; ++qt) ACC[kt][qt] = MFMA16(ka[kt][0], QB[qt][0], ((f32x4){0.f, 0.f, 0.f, 0.f})); \
        _Pragma("unroll") for (int kt = 0; kt < 4; ++kt) _Pragma("unroll") for (int qt = 0; qt < 2; ++qt) ACC[kt][qt] = MFMA16(ka[kt][1], QB[qt][1], ACC[kt][qt]); } while (0)
#define SC_ACCUM(ACC, hh_) do { const float w0 = WL[fr * 16 + (hh_)], w1 = WL[(16 + fr) * 16 + (hh_)]; \
        _Pragma("unroll") for (int kt = 0; kt < 4; ++kt) _Pragma("unroll") for (int qt = 0; qt < 2; ++qt) { const float w = qt ? w1 : w0; \
            const float s0 = __builtin_fmaf(w, __builtin_fabsf(ACC[kt][qt][0]), sc[kt][qt][0]); sc[kt][qt][0] = s0; \
            _Pragma("unroll") for (int r = 1; r < 4; ++r) { float s_ = sc[kt][qt][r]; asm("v_fma_f32 %0, %1, |%2|, %0" : "+v"(s_) : "v"(w), "v"(ACC[kt][qt][r]), "v"(s0)); sc[kt][qt][r] = s_; } } } while (0)
    for (int rs_ = 0; rs_ < REP_SCORE; ++rs_)
    {
    bf16x8 ka[4][2], kn[4][2];
    if (wave < ng) {
#pragma unroll
        for (int kt = 0; kt < 4; ++kt)
#pragma unroll
            for (int s = 0; s < 2; ++s) kn[kt][s] = *(const bf16x8*)(PK + (size_t)(wave * 64 + kt * 16 + fr) * 64 + s * 32 + fq * 8); }
    for (int g = wave; g < ng; g += 8) {
        const int kb = g * 64;
#pragma unroll
        for (int kt = 0; kt < 4; ++kt)
#pragma unroll
            for (int s = 0; s < 2; ++s) ka[kt][s] = kn[kt][s];
        if (g + 8 < ng) {
#pragma unroll
            for (int kt = 0; kt < 4; ++kt)
#pragma unroll
                for (int s = 0; s < 2; ++s) kn[kt][s] = *(const bf16x8*)(PK + (size_t)(kb + 512 + kt * 16 + fr) * 64 + s * 32 + fq * 8); }
        f32x4 sc[4][2], accA[4][2], accB[4][2]; bf16x8 qbA[2][2], qbB[2][2];
        SC_QLOAD(qbA, 16);
        SC_QLOAD(qbB, 0); SC_MMA(sc, qbA);
        __builtin_amdgcn_sched_barrier(0);
        SC_QLOAD(qbA, 1); SC_MMA(accA, qbB);
        __builtin_amdgcn_sched_barrier(0);
#pragma unroll 1
        for (int hh = 0; hh < 16; hh += 2) {
            SC_QLOAD(qbB, (hh + 2 < 16 ? hh + 2 : 15)); SC_MMA(accB, qbA); __builtin_amdgcn_sched_barrier(0);
            SC_ACCUM(accA, hh); __builtin_amdgcn_sched_barrier(0);
            SC_QLOAD(qbA, (hh + 3 < 16 ? hh + 3 : 15)); SC_MMA(accA, qbB); __builtin_amdgcn_sched_barrier(0);
            SC_ACCUM(accB, hh + 1); __builtin_amdgcn_sched_barrier(0);
        }
        if (rs_ == REP_SCORE - 1) {
#pragma unroll
        for (int kt = 0; kt < 4; ++kt)
#pragma unroll
            for (int qt = 0; qt < 2; ++qt) *(f32x4*)(scr + (size_t)(qt * 16 + fr) * 4096 + kb + kt * 16 + fq * 4) = sc[kt][qt]; }
    }
    }
#undef SC_QLOAD
#undef SC_MMA
#undef SC_ACCUM
    VM_WAIT(); __builtin_amdgcn_fence(__ATOMIC_RELEASE, "workgroup");
    __syncthreads();
    __builtin_amdgcn_fence(__ATOMIC_ACQUIRE, "workgroup");
    LAS unsigned* H = (LAS unsigned*)(F.lds + IX_H + wave * 2048); LAS float* CL = (LAS float*)(F.lds + IX_CL + wave * 1024);
    const float NINF = -__builtin_inff(), PINF = __builtin_inff();
#define SEL_FOR(body) _Pragma("unroll") for (int jj = 0; jj < 8; ++jj) { if (jj * 8 < nj) { _Pragma("unroll") for (int k8 = 0; k8 < 8; ++k8) { const int j = jj * 8 + k8; body } } }
#ifndef SEL_NPF
#define SEL_NPF 56
#endif
#define SEL_FORN(njv, body) _Pragma("unroll") for (int jj = 0; jj < 8; ++jj) { if (jj * 8 < (njv)) { _Pragma("unroll") for (int k8 = 0; k8 < 8; ++k8) { const int j = jj * 8 + k8; body } } }
    constexpr int NPF = SEL_NPF;
    float nx[NPF];
#pragma unroll
    for (int j = 0; j < NPF; ++j) nx[j] = NINF;
    { const int i0 = wave * 4, nj0 = (q0 + i0 + 1 + 63) >> 6; SEL_FORN(nj0, if (j < NPF) nx[j] = scr[(size_t)i0 * 4096 + j * 64 + lane]; ) }
#pragma unroll 1
    for (int rr_ = 0; rr_ < 4 * REP_SEL; ++rr_) { const int rr = rr_ & 3;
        const int i = wave * 4 + rr, q = q0 + i, nv = q + 1, nj = (nv + 63) >> 6;
        float sc[64];
#pragma unroll
        for (int j = 0; j < 64; ++j) sc[j] = NINF;
#pragma unroll
        for (int j = 0; j < NPF; ++j) { const int pos = j * 64 + lane; sc[j] = pos <= q ? nx[j] : NINF; }
        SEL_FOR( if (j >= NPF) { const int pos = j * 64 + lane; const float v = scr[(size_t)i * 4096 + pos]; sc[j] = pos <= q ? v : NINF; } )
        if (rr_ + 1 < 4 * REP_SEL) { const int i1 = wave * 4 + ((rr_ + 1) & 3), nj1 = (q0 + i1 + 1 + 63) >> 6; SEL_FORN(nj1, if (j < NPF) nx[j] = scr[(size_t)i1 * 4096 + j * 64 + lane]; ) }
        float tau = -3.0e38f;
        if (nv > 256) {
            float mn = -wave_max(-sc[0]), mx = wave_max(sc[0]);
            int r = 256; bool lvl0 = true;
#pragma unroll 1
            for (;;) {
                if (!(mx > mn)) { if (!lvl0) { tau = mn; break; } mx = mn + 1.0f; }
                const float scale = 512.0f / (mx - mn);
                *(LAS u32x4*)(H + 8 * lane) = (u32x4){0u, 0u, 0u, 0u}; *(LAS u32x4*)(H + 8 * lane + 4) = (u32x4){0u, 0u, 0u, 0u};
                if (lvl0) { SEL_FOR( const float v = sc[j]; int bb = (int)((v - mn) * scale); bb = bb < 0 ? 0 : (bb > 511 ? 511 : bb);
                                     if (v > NINF) __hip_atomic_fetch_add(H + bb, 1u, __ATOMIC_RELAXED, __HIP_MEMORY_SCOPE_WORKGROUP); ) }
                else { SEL_FOR( const float v = sc[j]; int bb = (int)((v - mn) * scale); bb = bb < 0 ? 0 : (bb > 511 ? 511 : bb);
                                if (v >= mn && v <= mx) __hip_atomic_fetch_add(H + bb, 1u, __ATOMIC_RELAXED, __HIP_MEMORY_SCOPE_WORKGROUP); ) }
                const u32x4 h0 = *(LAS u32x4*)(H + 8 * lane), h1 = *(LAS u32x4*)(H + 8 * lane + 4);
                const unsigned hb[8] = {h0.x, h0.y, h0.z, h0.w, h1.x, h1.y, h1.z, h1.w};
                const unsigned tot = (h0.x + h0.y) + (h0.z + h0.w) + (h1.x + h1.y) + (h1.z + h1.w);
                unsigned incl = tot;
#pragma unroll
                for (int o = 1; o < 64; o <<= 1) { const unsigned t = __shfl_down(incl, o); if (lane + o < 64) incl += t; }
                unsigned cum = incl - tot; int fb = 0; unsigned fabove = 0u, fcnt = 0u; bool found = false;
#pragma unroll
                for (int e = 7; e >= 0; --e) { const unsigned prev = cum; cum += hb[e]; if (prev < (unsigned)r && cum >= (unsigned)r) { fb = 8 * lane + e; fabove = prev; fcnt = hb[e]; found = true; } }
                const unsigned long long fbal = __ballot(found);
                const int src = fbal ? (int)__builtin_ctzll(fbal) : 0;
                const int bstar = __shfl(fb, src); const unsigned above = __shfl(fabove, src), cntb = __shfl(fcnt, src);
                r -= (int)above;
                const float lo_ = lvl0 ? -3.0e38f : mn, hi_ = lvl0 ? 3.0e38f : mx;
                if (cntb <= 256u) {
                    unsigned base = 0u;
                    SEL_FOR( const float v = sc[j]; int bb = (int)((v - mn) * scale); bb = bb < 0 ? 0 : (bb > 511 ? 511 : bb);
                             const bool m = (v >= lo_ && v <= hi_) && bb == bstar; const unsigned long long bal = __ballot(m);
                             if (bal) { const unsigned p = base + __builtin_amdgcn_mbcnt_hi((unsigned)(bal >> 32), __builtin_amdgcn_mbcnt_lo((unsigned)bal, 0u)); if (m) CL[p] = v; base += (unsigned)__popcll(bal); } )
                    float mine[4]; int cge[4];
#pragma unroll
                    for (int m4 = 0; m4 < 4; ++m4) { mine[m4] = (unsigned)(lane + 64 * m4) < cntb ? CL[lane + 64 * m4] : PINF; cge[m4] = 0; }
#pragma unroll 1
                    for (unsigned ci = 0; ci < cntb; ++ci) { const float c = CL[ci];
#pragma unroll
                        for (int m4 = 0; m4 < 4; ++m4) cge[m4] += (c >= mine[m4]) ? 1 : 0; }
                    float best = NINF;
#pragma unroll
                    for (int m4 = 0; m4 < 4; ++m4) if (cge[m4] >= r) best = fmaxf(best, mine[m4]);
                    tau = wave_max(best); break;
                }
                float nmn = PINF, nmx = NINF;
                SEL_FOR( const float v = sc[j]; int bb = (int)((v - mn) * scale); bb = bb < 0 ? 0 : (bb > 511 ? 511 : bb);
                         const bool m = (v >= lo_ && v <= hi_) && bb == bstar; nmn = fminf(nmn, m ? v : PINF); nmx = fmaxf(nmx, m ? v : NINF); )
                mn = -wave_max(-nmn); mx = wave_max(nmx); lvl0 = false;
            }
        }
        unsigned long long my = 0ull;
        SEL_FOR( const unsigned long long bal = __ballot(sc[j] >= tau); if (lane == j) my = bal; )
        a.mask[(tokq + i) * 64 + lane] = my;
    }
#undef SEL_FOR
#undef SEL_FORN
    __syncthreads();
}

struct DsaArgs { const bf16* proj; const unsigned long long* mask; const float* rel; bf16* mixcat; const unsigned char* k8; const unsigned char* v8t; };
__device__ __forceinline__ dsa::BlockRef<bf16, unsigned char> dsa_ref(const DsaArgs& a, int bh, int qb) {
    const int b = bh >> 3, h = bh & 7; const size_t row0 = (size_t)b * SEQ + (size_t)qb * 256;
    dsa::BlockRef<bf16, unsigned char> r;
    r.Q = a.proj + row0 * LDP + C_DQ + h * 128; r.K = a.proj + (size_t)b * SEQ * LDP + C_DK + h * 128; r.V = a.proj + (size_t)b * SEQ * LDP + C_DV + h * 128;
    r.O = (unsigned char*)a.mixcat + row0 * (2 * MIXP) + 2048 + h * 128; r.MK = a.mask + row0 * 64; r.P0 = qb * 256; r.K8 = a.k8 + (size_t)b * SEQ * 1024 + h * 128; r.V8 = a.v8t + (size_t)((b * 8 + h) * 128) * 4096;
    return r;
}
__device__ __forceinline__ void dsa_phase(Frame& F, char* lds, const DsaArgs& a) {
    constexpr int NITEM = 32 * 8;
    int L = F.vcu; if (L >= NITEM) return;
    dsa::Seam<bf16> S;
    int curh = -1;
    for (; L < NITEM; L += F.G) {
        const int bh = L >> 3, y = L & 7, h = bh & 7;
        if (h != curh) { __syncthreads(); curh = h;
            int tl = threadIdx.x; asm volatile("" : "+v"(tl));
            if (tl < 128) { const int n = tl; int bk = n; if (n >= 16) { bk = 16 + (int)(logf((float)n * 0.0625f) / 2.0794415416798357f * 16.0f); bk = bk > 31 ? 31 : bk; }
                ((float*)(lds + dsa::BL_OFF))[n] = (a.rel[bk * 8 + h] - a.rel[31 * 8 + h]) * 11.313708498984761f; }
            __syncthreads(); }
        const dsa::BlockRef<bf16, unsigned char> r0 = dsa_ref(a, bh, y), r1 = dsa_ref(a, bh, 15 - y);
        dsa::causal_swa_prime<bf16, unsigned char>(r0, lds, S);
        dsa::causal_swa_block<bf16, unsigned char>(r0, r1, SEQ, lds, S);
        dsa::causal_swa_block<bf16, unsigned char>(r1, r1, SEQ, lds, S);
    }
}
struct XaSchedA { const bf16* kv; const bf16* wxq; int c, G;
    __device__ __forceinline__ bool next(int i, pg8::Unit& u) const { const int id = c + i * G; if (id >= 128) return false; const int bh = id >> 3, pn = id & 7, b = bh >> 2, h = bh & 3;
        u.pm = bh; u.pn = pn; u.a = (const char*)(kv + (size_t)(b * 256) * 4096 + h * 512); u.b = (const char*)(wxq + (size_t)(pn * 256) * 2048 + h * 512); u.c = (size_t)(bh * 256) * 2048 + pn * 256; return true; }
    __device__ __forceinline__ void a_ready(const pg8::Unit&) const {}
    __device__ __forceinline__ void done(const pg8::Unit&) const {} };
struct XaSchedB { const bf16* kv; const bf16* wxo; int c, G;
    __device__ __forceinline__ bool next(int i, pg8::Unit& u) const { const int id = c + i * G; if (id >= 128) return false; const int bh = id >> 3, pm = id & 7, b = bh >> 2, h = bh & 3;
        u.pm = pm; u.pn = bh; u.a = (const char*)(wxo + (size_t)(pm * 256) * 2048 + h * 512); u.b = (const char*)(kv + (size_t)(b * 256) * 4096 + 2048 + h * 512); u.c = (size_t)b * 2048 * 1024 + (size_t)(pm * 256) * 1024 + h * 256; return true; }
    __device__ __forceinline__ void a_ready(const pg8::Unit&) const {}
    __device__ __forceinline__ void done(const pg8::Unit&) const {} };

template <int PN0, int NPN, int NKV, int LD, int SKIP_AT, int SKIP_LEN, bool F8, int T0, int SKEW = -1>
struct InKvSchedT { unsigned char* ws; int G, c;
    __device__ __forceinline__ bool next(int i, pg8::Unit& u) const { constexpr int nin = 64 * NPN; int L = i * G + c;
        if (SKEW >= 0 && G == 256) { static_assert(SKEW < 0 || nin == 256 * SKEW + 256, "skewed dealing"); if (i >= SKEW) { if (c < 128 || i >= SKEW + 2) return false; L = SKEW * 256 + (i - SKEW) * 128 + (c - 128); } }
        if (L >= nin + NKV) return false;
        if (L < nin) { pg8::static_order(0, 0, L, MTOK / 256, NPN, u.pm, u.pn); u.pn += PN0; if (u.pn >= SKIP_AT) u.pn += SKIP_LEN;
            const bf16* h = (const bf16*)(ws + (F8 ? WS_BUFB : WS_XB)); const bf16* win = (const bf16*)(ws + WS_WIN + (F8 ? (size_t)T0 * 256 * DM : (size_t)0));
            u.a = (const char*)(h + (size_t)u.pm * 256 * LD); u.b = (const char*)(win + (size_t)u.pn * 256 * LD); u.o = (bf16*)(ws + WS_PROJ); u.ldc = LDP; u.c = (size_t)u.pm * 256 * LDP + (size_t)u.pn * 256;
            u.rs = (const float*)(ws + WS_SS); u.osc = F8 ? 1.0f / FP8_WIN_SCALE : 1.0f; }
        else { const int id = L - nin; u.pm = id & 3; u.pn = id >> 2;
            u.a = (const char*)((const bf16*)(ws + WS_MEMN) + (size_t)u.pm * 256 * DM); u.b = (const char*)((const bf16*)(ws + WS_WXKV) + (size_t)u.pn * 256 * DM); u.o = (bf16*)(ws + WS_KV); u.ldc = 4096;
            u.c = (size_t)u.pm * 256 * 4096 + (size_t)u.pn * 256; u.rs = nullptr; u.osc = 1.0f; }
        return true; }
    __device__ __forceinline__ void a_ready(const pg8::Unit&) const {}
    __device__ __forceinline__ void done(const pg8::Unit&) const {} };
#define INPROJ_CALLS(T0_) do { \
        if constexpr ((T0_) < 24) { InKvSchedT<(T0_), 24 - (T0_), 0, DM / 2, 1 << 30, 0, true, (T0_), ((24 - (T0_)) * 64 - 256) / 256> S{w_, F.G, cid}; \
            pg8::gemm_phase<pg8::EpiBf16U, decltype(S), true, true, true>(F.lds + RING_OFF, DM / 2, DM / 2, DM / 2, S, E); } \
        { InKvSchedT<0, (T0_) + (LDP - FP8_IN_ROWS) / 256, 64, DM, (T0_), 24 - (T0_), false, (T0_)> S{w_, F.G, cid}; \
            pg8::gemm_phase<pg8::EpiBf16U, decltype(S), true, true>(F.lds + RING_OFF, DM, DM, DM, S, E); } } while (0)

#define KAS __attribute__((address_space(4)))
#define WSBASE() const KAS Args* ka_ = (const KAS Args*)__builtin_amdgcn_kernarg_segment_ptr(); asm volatile("" : "+s"(ka_)); unsigned char* w_ = ka_->ws; const float* g = ka_->in[2] + (size_t)l * 7 * DM; (void)g; \
    int cid = (int)blockIdx.x; asm volatile("" : "+s"(cid), "+s"(F.vcu), "+s"(F.wave), "+s"(F.G))
#define WIN ((bf16*)(w_ + WS_WIN))
#define WOUT ((bf16*)(w_ + WS_WOUT))
#define WXQ ((bf16*)(w_ + WS_WXQ))
#define WXKV ((bf16*)(w_ + WS_WXKV))
#define WXO ((bf16*)(w_ + WS_WXO))
#define WFI ((bf16*)(w_ + WS_WFI))
#define WFO ((bf16*)(w_ + WS_WFO))
#define MEMN ((bf16*)(w_ + WS_MEMN))
#define KV ((bf16*)(w_ + WS_KV))
#define AT ((bf16*)(w_ + WS_AT))
#define BT2 ((bf16*)(w_ + WS_BT2))
#define PROJ ((bf16*)(w_ + WS_PROJ))
#define ACT ((bf16*)(w_ + WS_ACT))
#define LOGIT ((float*)(w_ + WS_LOGIT))
#define PROB ((bf16*)(w_ + WS_PROB))
#define BUFA ((bf16*)(w_ + WS_BUFA))
#define BUFB ((bf16*)(w_ + WS_BUFB))
#define SCR ((float*)(w_ + WS_SCR))
#define MASK ((unsigned long long*)((unsigned char*)ka_->out + DO_MASK))
#define PART ((float*)(w_ + WS_PART))
#define DEC ((float*)(w_ + WS_DEC))
#define BCUM ((float*)((unsigned char*)ka_->out + DO_BCUM))
#define XB ((bf16*)(w_ + WS_XB))
#define SS ((float*)(w_ + WS_SS))
#define FUSED_NORM(inst, gpost, outf, xb8) do { int pm_, pn_; pg8::static_order(0, 256, cid, MTOK / 256, DM / 256, pm_, pn_); \
    panel_sync((unsigned*)(F.ctl + CW_PANEL + ((inst) * 64 + pm_) * 64), (unsigned*)(F.ctl + CW_BAR) + XB_TMO); \
    norm_rows(pm_ * 256 + pn_ * 64, pm_ * 256 + pn_ * 64 + 64, F.wave, NWAVES, XB, BUFA, PART, (gpost), SS, (outf), (xb8)); } while (0)
#define FUSED (FUSE_NORM && F.G == 256)
constexpr int NPH = 14, NPHASE = NPH * DEPTH;
struct Args { const float* in[14]; float* out; unsigned char* ws; int ph_lo, ph_hi; };
#ifndef REPEAT_MASK
#define REPEAT_MASK 0
#endif
#ifndef REP_GLA
#define REP_GLA 1
#endif
__global__ void __launch_bounds__(NTHR, 2) hymba_fwd(Args args) {
    extern __shared__ __attribute__((aligned(16))) unsigned char lds[];
    Frame F;
    F.lds = (LAS unsigned char*)lds;
    F.MISC = (volatile LAS unsigned*)(F.lds + MISC_OFF);
    F.tid = threadIdx.x; F.lane = F.tid & 63; F.wave = __builtin_amdgcn_readfirstlane(F.tid >> 6);
    F.G = gridDim.x; { const int bx = blockIdx.x; F.vcu = (F.G % 8 == 0) ? (bx % 8) * (F.G / 8) + bx / 8 : bx; }
    F.ws = nullptr;
    F.ctl = (gu32*)(args.ws + WS_CTL);
    for (int u = F.tid; u < (LDS_BYTES - LDSCTL_OFF) / 4; u += NTHR) ((LAS unsigned*)(F.lds + LDSCTL_OFF))[u] = 0u;
    __syncthreads();
    XcdBarrier bar; bar.bar = (unsigned*)(F.ctl + CW_BAR); bar.x = 0; bar.st = nullptr;
#if !MK_MULTI
    bar = xcd_barrier_post((unsigned*)(F.ctl + CW_BAR), F.MISC + 8);
#endif
    const int lo = args.ph_lo, hi = args.ph_hi;
#define IN(k) (lo <= pb + (k) && pb + (k) < hi)
#define PHASE(k) for (int rep_ = 0; rep_ < (IN(k) ? 1 + ((REPEAT_MASK >> (k)) & 1) : 0); ++rep_)
#ifndef REP_BAR
#define REP_BAR 1
#endif
#ifndef REP_NORM
#define REP_NORM 0
#endif
#define SEAM(k) do { if (!MK_MULTI && IN(k) && lo <= pb + (k) + 1 && pb + (k) + 1 < hi) { for (int rb_ = 0; rb_ < REP_BAR; ++rb_) xcd_barrier(bar); } } while (0)
#define MKGA() GlaArgs ga; ga.proj = PROJ; ga.w2 = ka_->in[4] + (size_t)l * 16 * 512; ga.bg = ka_->in[5] + (size_t)l * 512; ga.ghead = ka_->in[6] + (size_t)l * 256; ga.state = BUFA; ga.dec = DEC; ga.bcum = BCUM; ga.mixcat = BUFB

    for (int l = 0; l < DEPTH; ++l) {
        const int pb = l * NPH;
        PHASE(0) { WSBASE(); P0Args pa; pa.ws = w_; pa.x = ka_->in[0]; pa.mem = ka_->in[1]; pa.gains = ka_->in[2]; pa.w_in = ka_->in[3] + (size_t)l * DM * D_IN; pa.w_out = ka_->in[8] + (size_t)l * DM * DM; pa.w_xq = ka_->in[9] + (size_t)l * DM * DM;
            pa.w_xkv = ka_->in[10] + (size_t)l * DM * 2 * DM; pa.w_xo = ka_->in[11] + (size_t)l * DM * DM; pa.w_fi = ka_->in[12] + (size_t)l * DM * 2 * DFF; pa.w_fo = ka_->in[13] + (size_t)l * DFF * DM; pa.layer = l; pa.fp8 = (FP8_LAYERS >> l) & 1; pa.fp8in = (FP8_INPROJ >> l) & 1; pa.fp8fo = (FP8_FFN_OUT >> l) & 1;
            p0_prologue(F, pa); }
        SEAM(0);
        PHASE(1) { WSBASE(); pg8::EpiBf16U E{(bf16*)(w_ + WS_IKC), (unsigned char*)ka_->out + DO_V8T, (unsigned char*)ka_->out + DO_K8};
#if FP8_INPROJ == 3
            if (l == 0) INPROJ_CALLS(FP8_IN_T0_L0); else INPROJ_CALLS(FP8_IN_T0_L1);
#elif FP8_INPROJ == 2
            if (l == 0) INPROJ_CALLS(24); else INPROJ_CALLS(FP8_IN_T0_L1);
#elif FP8_INPROJ == 1
            if (l == 0) INPROJ_CALLS(FP8_IN_T0_L0); else INPROJ_CALLS(24);
#else
            INPROJ_CALLS(24);
#endif
        }
        SEAM(1);
        PHASE(2) { WSBASE(); MKGA();
#ifndef NO_GLA
            for (int rg_ = 0; rg_ < REP_GLA; ++rg_)
            for (int u = F.vcu; u < 1024; u += F.G) gla_a_unit(F, ga, u >> 8, (u >> 2) & 63, u & 3);
#endif
#ifndef NO_IDX
            IdxArgs ia; ia.proj = PROJ; ia.ikc = (const bf16*)(w_ + WS_IKC); ia.scr = SCR; ia.mask = MASK;
            for (int p = F.vcu; p < 256; p += F.G) { const int b = p >> 6, pp = p & 63; idx_unit(F, ia, b, pp * 32); idx_unit(F, ia, b, (127 - pp) * 32); }
#endif
        }
        SEAM(2);
        PHASE(3) { WSBASE();
            if (cid < F.G / 2) { XaSchedA S{KV, WXQ, cid, F.G / 2}; pg8::EpiBf16 E{AT, DM}; pg8::gemm_phase<pg8::EpiBf16, XaSchedA, true, true>(F.lds + RING_OFF, 512, 4096, DM, S, E); }
            else { XaSchedB S{KV, WXO, cid - F.G / 2, F.G - F.G / 2}; pg8::EpiBf16 E{BT2, 1024}; pg8::gemm_phase<pg8::EpiBf16, XaSchedB, true, true>(F.lds + RING_OFF, 512, DM, 4096, S, E); }
            gla_scan(F, BUFA, DEC); }
        SEAM(3);
        PHASE(4) { WSBASE(); MKGA();
#ifndef NO_GLA
            for (int rg_ = 0; rg_ < REP_GLA; ++rg_)
            for (int u = F.vcu; u < 1024; u += F.G) gla_c_unit(F, ga, u >> 8, (u >> 2) & 63, u & 3);
#endif
#ifndef NO_DSA
            DsaArgs da; da.proj = PROJ; da.mask = MASK; da.rel = ka_->in[7]; da.mixcat = BUFB; da.k8 = (const unsigned char*)ka_->out + DO_K8; da.v8t = (const unsigned char*)ka_->out + DO_V8T;
#ifndef REP_DSA
#define REP_DSA 1
#endif
            for (int rd_ = 0; rd_ < REP_DSA; ++rd_) dsa_phase(F, (char*)lds + RING_OFF, da);
#endif
        }
        SEAM(4);
        PHASE(5) { WSBASE(); pg8::PlainSched S{BUFB, WOUT, MIXP, MIXP, MTOK / 256, DM / 256, F.G, cid, 0, 0, 0, 0}; pg8::EpiBf16Part E{BUFA, PART, 1.0f};
            pg8::gemm_phase<pg8::EpiBf16Part, pg8::PlainSched, true, true, false, 16>(F.lds + RING_OFF, MIXP, MIXP, MIXP, S, E);
            if (FUSED) FUSED_NORM(l * 3 + 0, g + 1 * DM, (float*)nullptr, (unsigned char*)nullptr); }
        if (!FUSED) SEAM(5);
        PHASE(6) { WSBASE(); if (!FUSED) norm_phase(F, XB, BUFA, PART, g + 1 * DM, SS, nullptr); }
        SEAM(6);
        PHASE(7) { WSBASE(); pg8::PlainSched S{XB, AT, DM, DM, MTOK / 256, 1024 / 256, F.G, cid, 16, (size_t)1024 * DM, 0, 0};
#if FUSE_SOFTMAX
            pg8::EpiSoftmaxP E{PROB, SS, (LAS float*)(F.lds + LDSCTL_OFF + 1024), (LAS float*)(F.lds + LDSCTL_OFF + 1024 + 4096)};
            pg8::gemm_phase<pg8::EpiSoftmaxP, pg8::PlainSched, true, true>(F.lds + RING_OFF, DM, DM, DM, S, E); }
#else
            pg8::EpiF32 E{LOGIT, 1024};
            pg8::gemm_phase<pg8::EpiF32, pg8::PlainSched, true, true>(F.lds + RING_OFF, DM, DM, DM, S, E); }
        SEAM(7);
#endif
        PHASE(8) { WSBASE(); if (!FUSE_SOFTMAX) xsoftmax_phase(F, LOGIT, PROB, SS); }
        SEAM(8);
        PHASE(9) { WSBASE(); pg8::PlainSched S{PROB, BT2, 1024, 1024, MTOK / 256, DM / 256, F.G, cid, 16, (size_t)DM * 1024, 0, 0}; pg8::EpiBf16Part E{BUFA, PART, 1.0f};
            pg8::gemm_phase<pg8::EpiBf16Part, pg8::PlainSched, true, true>(F.lds + RING_OFF, 1024, 1024, 1024, S, E);
            if (FUSED) FUSED_NORM(l * 3 + 1, g + 3 * DM, (float*)nullptr, ((FP8_LAYERS >> l) & 1) ? (unsigned char*)BUFB : (unsigned char*)nullptr); }
        if (!FUSED) SEAM(9);
        PHASE(10) { WSBASE(); if (!FUSED) norm_phase(F, XB, BUFA, PART, g + 3 * DM, SS, nullptr, ((FP8_LAYERS >> l) & 1) ? (unsigned char*)BUFB : nullptr); }
        SEAM(10);
        PHASE(11) { WSBASE();
            if ((FP8_LAYERS >> l) & 1) { pg8::PlainSched S{(const bf16*)BUFB, WFI, DM / 2, DM / 2, MTOK / 256, 2 * DFF / 256, F.G, cid, 0, 0, 0, 0}; pg8::EpiSwiglu8 E{(unsigned char*)ACT, DFF, SS, 1.0f / FP8_WFI_SCALE, FP8_ACT_SCALE};
                pg8::gemm_phase<pg8::EpiSwiglu8, pg8::PlainSched, true, true, true>(F.lds + RING_OFF, DM / 2, DM / 2, DM / 2, S, E); }
            else if ((FP8_FFN_OUT >> l) & 1) { pg8::PlainSched S{XB, WFI, DM, DM, MTOK / 256, 2 * DFF / 256, F.G, cid, 0, 0, 0, 0}; pg8::EpiSwiglu8 E{(unsigned char*)ACT, DFF, SS, 1.0f, FP8_ACT_SCALE};
                pg8::gemm_phase<pg8::EpiSwiglu8, pg8::PlainSched, true, true>(F.lds + RING_OFF, DM, DM, DM, S, E); }
            else { pg8::PlainSched S{XB, WFI, DM, DM, MTOK / 256, 2 * DFF / 256, F.G, cid, 0, 0, 0, 0}; pg8::EpiSwiglu E{ACT, DFF, SS};
                pg8::gemm_phase<pg8::EpiSwiglu, pg8::PlainSched, true, true>(F.lds + RING_OFF, DM, DM, DM, S, E); } }
        SEAM(11);
        PHASE(12) { WSBASE();
            if ((FP8_FFN_OUT >> l) & 1) { pg8::PlainSched S{ACT, WFO, DFF / 2, DFF / 2, MTOK / 256, DM / 256, F.G, cid, 0, 0, 0, 0}; pg8::EpiBf16Part E{BUFA, PART, 1.0f / (FP8_WFO_SCALE * FP8_ACT_SCALE)};
                pg8::gemm_phase<pg8::EpiBf16Part, pg8::PlainSched, true, true, true>(F.lds + RING_OFF, DFF / 2, DFF / 2, DFF / 2, S, E); }
            else { pg8::PlainSched S{ACT, WFO, DFF, DFF, MTOK / 256, DM / 256, F.G, cid, 0, 0, 0, 0}; pg8::EpiBf16Part E{BUFA, PART, 1.0f};
                pg8::gemm_phase<pg8::EpiBf16Part, pg8::PlainSched, true, true>(F.lds + RING_OFF, DFF, DFF, DFF, S, E); }
            if (FUSED) FUSED_NORM(l * 3 + 2, g + 5 * DM, l + 1 < DEPTH ? (float*)nullptr : ka_->out, (l + 1 < DEPTH && ((FP8_INPROJ >> (l + 1)) & 1)) ? (unsigned char*)BUFB : (unsigned char*)nullptr); }
        if (!FUSED) SEAM(12);
        PHASE(13) { WSBASE(); if (!FUSED) norm_phase(F, XB, BUFA, PART, g + 5 * DM, SS, l + 1 < DEPTH ? nullptr : ka_->out, (l + 1 < DEPTH && ((FP8_INPROJ >> (l + 1)) & 1)) ? (unsigned char*)BUFB : nullptr); }
        SEAM(13);
    }
#undef IN
#undef SEAM
#undef PHASE
}

extern "C" void kernel_launch(void* const* d_in, const int* in_sizes, int n_in, void* d_out, int out_size, void* d_ws, size_t ws_size, hipStream_t stream) {
    static int grid = 0;
    if (grid == 0) {
        if (n_in != 14 || out_size != MTOK * DM || ws_size < WS_END) { fprintf(stderr, "kernel_launch: unexpected shapes (n_in %d, out %d, ws %zu < %zu)\n", n_in, out_size, ws_size, (size_t)WS_END); grid = -1; return; }
        int dev = 0, cus = 0, per_cu = 0;
        if (hipGetDevice(&dev) != hipSuccess || hipDeviceGetAttribute(&cus, hipDeviceAttributeMultiprocessorCount, dev) != hipSuccess) { grid = -1; return; }
        if (hipFuncSetAttribute((const void*)hymba_fwd, hipFuncAttributeMaxDynamicSharedMemorySize, LDS_BYTES) != hipSuccess) { fprintf(stderr, "kernel_launch: hipFuncSetAttribute failed\n"); grid = -1; return; }
        if (hipOccupancyMaxActiveBlocksPerMultiprocessor(&per_cu, (const void*)hymba_fwd, NTHR, LDS_BYTES) != hipSuccess || per_cu < 1) { fprintf(stderr, "kernel_launch: occupancy query says %d workgroups per CU\n", per_cu); }
        (void)hipGetLastError();
        grid = cus;
    }
    if (grid < 0) return;
    if (hipMemsetAsync((char*)d_ws + WS_CTL, 0, CTL_ZERO_BYTES, stream) != hipSuccess) return;
    Args a{};
    for (int i = 0; i < 14; ++i) a.in[i] = (const float*)d_in[i];
    a.out = (float*)d_out; a.ws = (unsigned char*)d_ws;
#if MK_MULTI
    for (int p = 0; p < NPHASE; ++p) { a.ph_lo = p; a.ph_hi = p + 1; hipLaunchKernelGGL(hymba_fwd, dim3(grid), dim3(NTHR), LDS_BYTES, stream, a); }
#else
    a.ph_lo = 0; a.ph_hi = NPHASE; hipLaunchKernelGGL(hymba_fwd, dim3(grid), dim3(NTHR), LDS_BYTES, stream, a);
#endif
    (void)in_sizes;
}
```
